# Optimizing an MI355X kernel written in HIP

```python
import math
import jax, jax.numpy as jnp
from jax import lax
import numpy as np

D_MODEL = 1024
BATCH = 16
SEQ = 4096
DEPTH = 2

CHUNK = 64
N_LEFT_CHUNKS = 8
D_S5 = D_MODEL // 4
S5_GROUP = 16
S5_GROUPS = D_S5 // S5_GROUP
S5_STATE = 64
D_ATT = D_MODEL // 2
ATT_HEAD_DIM = 64
ATT_HEADS = D_ATT // ATT_HEAD_DIM
MAX_REL = 128
D_CONV = D_MODEL // 4
CONV_WIDTH = 31
N_BRANCHES = 3
D_FF = 2816
EPS = 1e-6
DT_MIN = 1e-3
DT_MAX = 1e-1

SPLIT_POINTS = [D_S5, D_S5 + D_ATT, D_S5 + 2 * D_ATT, D_S5 + 3 * D_ATT,
                D_S5 + 3 * D_ATT + 2 * D_CONV]
IN_COLS = D_S5 + 3 * D_ATT + 2 * D_CONV + N_BRANCHES * D_MODEL

kernel_name = "hybrid_s5_chunkattn_conformer_conv_gated"


def rmsnorm(x, g):
    xf = x.astype(jnp.float32)
    y = xf * lax.rsqrt(jnp.mean(xf * xf, axis=-1, keepdims=True) + EPS)
    return (y * g.astype(jnp.float32)).astype(x.dtype)


def layernorm(x, g, b):
    xf = x.astype(jnp.float32)
    mu = jnp.mean(xf, axis=-1, keepdims=True)
    var = jnp.mean(jnp.square(xf - mu), axis=-1, keepdims=True)
    y = (xf - mu) * lax.rsqrt(var + EPS)
    return (y * g.astype(jnp.float32) + b.astype(jnp.float32)).astype(x.dtype)


def swiglu_ffn(x, w_up, w_down):
    a, b = jnp.split(x @ w_up, 2, axis=-1)
    return (jax.nn.silu(a) * b) @ w_down


def _complex_linear_combine(e1, e2):
    a1r, a1i, b1r, b1i = e1
    a2r, a2i, b2r, b2i = e2
    ar = a2r * a1r - a2i * a1i
    ai = a2r * a1i + a2i * a1r
    br = a2r * b1r - a2i * b1i + b2r
    bi = a2r * b1i + a2i * b1r + b2i
    return (ar, ai, br, bi)


def s5_mixer(u, lambda_re, lambda_im, log_dt, b_re, b_im, c_re, c_im, d_skip, w_glu):
    bsz, seq, _ = u.shape
    f32 = jnp.float32
    uf = u.astype(f32).reshape(bsz, seq, S5_GROUPS, S5_GROUP)
    lr = jnp.minimum(lambda_re.astype(f32), -1e-4)
    li = lambda_im.astype(f32)
    dt = jnp.exp(log_dt.astype(f32))[:, None]
    mag = jnp.exp(lr * dt)
    ar = mag * jnp.cos(li * dt)
    ai = mag * jnp.sin(li * dt)
    den = lr * lr + li * li
    coef_r = ((ar - 1.0) * lr + ai * li) / den
    coef_i = (ai * lr - (ar - 1.0) * li) / den
    br = b_re.astype(f32)
    bi = b_im.astype(f32)
    bbar_r = coef_r[..., None] * br - coef_i[..., None] * bi
    bbar_i = coef_r[..., None] * bi + coef_i[..., None] * br
    bu_r = jnp.einsum('bsgc,gpc->bsgp', uf, bbar_r)
    bu_i = jnp.einsum('bsgc,gpc->bsgp', uf, bbar_i)
    a_r = jnp.broadcast_to(ar, bu_r.shape)
    a_i = jnp.broadcast_to(ai, bu_i.shape)
    _, _, xr, xi = lax.associative_scan(_complex_linear_combine, (a_r, a_i, bu_r, bu_i), axis=1)
    y = (jnp.einsum('bsgp,gcp->bsgc', xr, c_re.astype(f32))
         - jnp.einsum('bsgp,gcp->bsgc', xi, c_im.astype(f32))
         + d_skip.astype(f32).reshape(S5_GROUPS, S5_GROUP) * uf)
    y = jax.nn.gelu(y.reshape(bsz, seq, D_S5)).astype(u.dtype)
    a, g = jnp.split(y @ w_glu, 2, axis=-1)
    return a * jax.nn.sigmoid(g)


def chunked_attention(q, k, v, q_gain, k_gain, rel_bias):
    bsz, seq, _ = q.shape
    n_chunks = seq // CHUNK
    q = rmsnorm(q.reshape(bsz, seq, ATT_HEADS, ATT_HEAD_DIM), q_gain)
    k = rmsnorm(k.reshape(bsz, seq, ATT_HEADS, ATT_HEAD_DIM), k_gain)
    v = v.reshape(bsz, seq, ATT_HEADS, ATT_HEAD_DIM)
    pad = N_LEFT_CHUNKS * CHUNK
    band = (N_LEFT_CHUNKS + 1) * CHUNK
    k_pad = jnp.pad(k, ((0, 0), (pad, 0), (0, 0), (0, 0)))
    v_pad = jnp.pad(v, ((0, 0), (pad, 0), (0, 0), (0, 0)))
    qi = jnp.arange(CHUNK)[:, None]
    kj = jnp.arange(band)[None, :]
    rel = jnp.clip(pad + qi - kj, -MAX_REL, MAX_REL) + MAX_REL
    bias = rel_bias.astype(jnp.float32)[:, rel]
    scale = ATT_HEAD_DIM ** -0.5

    def one_chunk(c):
        start = c * CHUNK
        qc = lax.dynamic_slice_in_dim(q, start, CHUNK, axis=1)
        kc = lax.dynamic_slice_in_dim(k_pad, start, band, axis=1)
        vc = lax.dynamic_slice_in_dim(v_pad, start, band, axis=1)
        s = jnp.einsum('bqhd,bkhd->bhqk', qc, kc).astype(jnp.float32) * scale + bias[None]
        valid = kj >= (pad - start)
        s = jnp.where(valid[None, None], s, -1e30)
        p = jax.nn.softmax(s, axis=-1).astype(vc.dtype)
        return jnp.einsum('bhqk,bkhd->bqhd', p, vc)

    out = lax.map(one_chunk, jnp.arange(n_chunks))
    return out.transpose(1, 0, 2, 3, 4).reshape(bsz, seq, D_ATT)


def conv_module(z, w_dw, b_dw, ln_g, ln_b, w_pw):
    a, g = jnp.split(z, 2, axis=-1)
    h = a * jax.nn.sigmoid(g)
    h = lax.conv_general_dilated(
        h, w_dw[:, None, :], window_strides=(1,), padding=[(CONV_WIDTH - 1, 0)],
        dimension_numbers=('NWC', 'WIO', 'NWC'), feature_group_count=D_CONV) + b_dw
    h = jax.nn.silu(layernorm(h, ln_g, ln_b))
    return h @ w_pw


def setup_inputs(seed: int = 0) -> dict:
    key = jax.random.key(seed)
    ks = jax.random.split(key, 32)
    L = DEPTH

    def nrm(k, shape, scale):
        return jax.random.normal(k, shape, jnp.float32) * scale

    n_idx = jnp.arange(S5_STATE, dtype=jnp.float32)
    lam_im = jnp.broadcast_to(math.pi * n_idx, (L, S5_GROUPS, S5_STATE))
    return {
        "x": nrm(ks[0], (BATCH, SEQ, D_MODEL), 1.0),
        "ffn1_norm": 1.0 + nrm(ks[1], (L, D_MODEL), 0.02),
        "ffn1_w_up": nrm(ks[2], (L, D_MODEL, 2 * D_FF), D_MODEL ** -0.5),
        "ffn1_w_down": nrm(ks[3], (L, D_FF, D_MODEL), D_FF ** -0.5),
        "mix_norm": 1.0 + nrm(ks[4], (L, D_MODEL), 0.02),
        "w_in": nrm(ks[5], (L, D_MODEL, IN_COLS), D_MODEL ** -0.5),
        "b_gate": nrm(ks[6], (L, N_BRANCHES * D_MODEL), 0.01),
        "s5_lambda_re": -0.5 + nrm(ks[7], (L, S5_GROUPS, S5_STATE), 0.01),
        "s5_lambda_im": lam_im + nrm(ks[8], (L, S5_GROUPS, S5_STATE), 0.01),
        "s5_log_dt": jax.random.uniform(ks[9], (L, S5_GROUPS), jnp.float32,
                                        math.log(DT_MIN), math.log(DT_MAX)),
        "s5_b_re": nrm(ks[10], (L, S5_GROUPS, S5_STATE, S5_GROUP), (2 * S5_GROUP) ** -0.5),
        "s5_b_im": nrm(ks[11], (L, S5_GROUPS, S5_STATE, S5_GROUP), (2 * S5_GROUP) ** -0.5),
        "s5_c_re": nrm(ks[12], (L, S5_GROUPS, S5_GROUP, S5_STATE), (2 * S5_STATE) ** -0.5),
        "s5_c_im": nrm(ks[13], (L, S5_GROUPS, S5_GROUP, S5_STATE), (2 * S5_STATE) ** -0.5),
        "s5_d": nrm(ks[14], (L, D_S5), 1.0),
        "s5_w_glu": nrm(ks[15], (L, D_S5, 2 * D_S5), D_S5 ** -0.5),
        "w_br_s5": nrm(ks[16], (L, D_S5, D_MODEL), D_S5 ** -0.5),
        "attn_q_gain": 1.0 + nrm(ks[17], (L, ATT_HEAD_DIM), 0.02),
        "attn_k_gain": 1.0 + nrm(ks[18], (L, ATT_HEAD_DIM), 0.02),
        "attn_rel_bias": nrm(ks[19], (L, ATT_HEADS, 2 * MAX_REL + 1), 0.1),
        "w_br_attn": nrm(ks[20], (L, D_ATT, D_MODEL), D_ATT ** -0.5),
        "conv_w_dw": nrm(ks[21], (L, CONV_WIDTH, D_CONV), CONV_WIDTH ** -0.5),
        "conv_b_dw": nrm(ks[22], (L, D_CONV), 0.01),
        "conv_ln_g": 1.0 + nrm(ks[23], (L, D_CONV), 0.02),
        "conv_ln_b": nrm(ks[24], (L, D_CONV), 0.01),
        "w_br_conv": nrm(ks[25], (L, D_CONV, D_MODEL), D_CONV ** -0.5),
        "w_out": nrm(ks[26], (L, D_MODEL, D_MODEL), D_MODEL ** -0.5),
        "ffn2_norm": 1.0 + nrm(ks[27], (L, D_MODEL), 0.02),
        "ffn2_w_up": nrm(ks[28], (L, D_MODEL, 2 * D_FF), D_MODEL ** -0.5),
        "ffn2_w_down": nrm(ks[29], (L, D_FF, D_MODEL), D_FF ** -0.5),
    }


def reference(x, ffn1_norm, ffn1_w_up, ffn1_w_down, mix_norm, w_in, b_gate,
              s5_lambda_re, s5_lambda_im, s5_log_dt, s5_b_re, s5_b_im, s5_c_re, s5_c_im,
              s5_d, s5_w_glu, w_br_s5, attn_q_gain, attn_k_gain, attn_rel_bias, w_br_attn,
              conv_w_dw, conv_b_dw, conv_ln_g, conv_ln_b, w_br_conv, w_out,
              ffn2_norm, ffn2_w_up, ffn2_w_down):
    for l in range(DEPTH):
        x = x + 0.5 * swiglu_ffn(rmsnorm(x, ffn1_norm[l]), ffn1_w_up[l], ffn1_w_down[l])

        h = rmsnorm(x, mix_norm[l])
        proj = h @ w_in[l]
        u_s5, q, k, v, z_conv, gate_logits = jnp.split(proj, SPLIT_POINTS, axis=-1)

        y_s5 = s5_mixer(u_s5, s5_lambda_re[l], s5_lambda_im[l], s5_log_dt[l],
                        s5_b_re[l], s5_b_im[l], s5_c_re[l], s5_c_im[l],
                        s5_d[l], s5_w_glu[l]) @ w_br_s5[l]
        y_attn = chunked_attention(q, k, v, attn_q_gain[l], attn_k_gain[l],
                                   attn_rel_bias[l]) @ w_br_attn[l]
        y_conv = conv_module(z_conv, conv_w_dw[l], conv_b_dw[l], conv_ln_g[l],
                             conv_ln_b[l], w_br_conv[l])

        gates = jax.nn.sigmoid(gate_logits + b_gate[l])
        g_s5, g_attn, g_conv = jnp.split(gates, N_BRANCHES, axis=-1)
        merged = g_s5 * y_s5 + g_attn * y_attn + g_conv * y_conv
        x = x + merged @ w_out[l]

        x = x + 0.5 * swiglu_ffn(rmsnorm(x, ffn2_norm[l]), ffn2_w_up[l], ffn2_w_down[l])
    return x
```

```cpp
#include <hip/hip_runtime.h>
#include <hip/hip_cooperative_groups.h>
#include <cstdio>
#include <cstdint>
namespace cg = cooperative_groups;
namespace pg8 {
#define PG8_LAS __attribute__((address_space(3)))
typedef unsigned short bf16_t;
typedef short bf16x8 __attribute__((ext_vector_type(8)));
typedef float f32x4 __attribute__((ext_vector_type(4)));
typedef unsigned u32x4 __attribute__((ext_vector_type(4)));
constexpr int BM = 256, BK = 64, HALF = 128, HTB = HALF * BK * 2  , STAGE_BYTES = 8 * HTB, NXCD = 8, WGM = 8;

__host__ __device__ __forceinline__ int lds_byte(int r, int c) { const int st = (r >> 4) * 2 + (c >> 5), rr = r & 15, cc = c & 31, ob = rr * 64 + cc * 2; return st * 1024 + (ob ^ (((ob >> 9) & 1) << 5)); }
__host__ __device__ __forceinline__ void stage_rc(int b, int& R, int& C) { const int st = b / 1024, sb = b % 1024, swz = sb ^ (((sb >> 9) & 1) << 5); R = (st >> 1) * 16 + swz / 64; C = (st & 1) * 32 + (swz % 64) / 2; }
__host__ __device__ __forceinline__ int perm32(int rho) { const int n = rho >> 4, i = rho & 15; return 8 * (i >> 2) + 4 * n + (i & 3); }

struct Unit { int pm, pn; int koff = 0, nt = 0, seg = 0; };
struct Gemm { const bf16_t* A; const bf16_t* Bt; int M, N, K, lda, ldb; };

struct StaticOrder {
    int nM, nN, nwg, G, c;
    __host__ __device__ void init(int M, int N, int G_, int c_) { nM = M / BM; nN = N / BM; nwg = nM * nN; G = G_; c = c_; }
    __host__ __device__ bool next(int i, Unit& u) const {
        const long L = (long)i * G + c; if (L >= nwg) return false;
        int wgid = (int)L; { const int q = nwg / NXCD, r = nwg % NXCD, xcd = wgid % NXCD, off = wgid / NXCD; wgid = (xcd < r ? xcd * (q + 1) : r * (q + 1) + (xcd - r) * q) + off; }
        const int nig = WGM * nN, gid = wgid / nig, fm = gid * WGM, gsz = (nM - fm) < WGM ? (nM - fm) : WGM;
        u.pm = fm + ((wgid % nig) % gsz); u.pn = (wgid % nig) / gsz; return true;
    }
    __device__ __forceinline__ void a_ready(const Unit&) const {}
    __device__ __forceinline__ void done(const Unit&) const {}
};

__device__ __forceinline__ unsigned cvt_pk_bf16(float lo, float hi) { unsigned r; asm volatile("v_cvt_pk_bf16_f32 %0, %1, %2" : "=v"(r) : "v"(lo), "v"(hi)); return r; }
typedef float f32x2 __attribute__((ext_vector_type(2)));
__device__ __forceinline__ f32x2 gelu_pk(f32x2 v) {
    const f32x2 av = __builtin_elementwise_abs(v), d = av * 0.2316418882f + 1.0f;
    f32x2 t; t.x = __builtin_amdgcn_rcpf(d.x); t.y = __builtin_amdgcn_rcpf(d.y);
    f32x2 q = t * 0.5307027145f + (-0.7265760135f); q = q * t + 0.7107068705f; q = q * t + (-0.142248368f); q = q * t + 0.127414796f; q = q * t;
    const f32x2 s = (v * v) * (-0.72134752044f);
    f32x2 e; e.x = __builtin_amdgcn_exp2f(s.x); e.y = __builtin_amdgcn_exp2f(s.y);
    const f32x2 m = v * (q * e), r = v - m;
    f32x2 o; o.x = v.x < 0.f ? m.x : r.x; o.y = v.y < 0.f ? m.y : r.y; return o;
}

template <int ACT  > struct EpiBf16 {
    static constexpr bool PERM = true, AFTER_DRAIN = false; static_assert(ACT == 0 || ACT == 1, "EpiBf16: ACT is 0 (none) or 1 (gelu_pk)");
    bf16_t* O; int ldc; const float* bias; int split_cols; size_t split_stride; float scale0;
    __device__ __forceinline__ void operator()(const f32x4 (&acc)[2][2][4][2], const Unit& u, int wr, int wc, int fr, int fq) const {
        const int row0 = u.pm * BM + wr * 64 + fr; int colt = u.pn * BM; bf16_t* base = O;
        float sc = 1.f; if (split_cols) { const int t = colt / split_cols; base += (size_t)t * split_stride; colt -= t * split_cols; if (t == 0) sc = scale0; }
        const int col0 = colt + wc * 32 + 8 * fq, bcol0 = u.pn * BM + wc * 32 + 8 * fq;
        f32x4 bv[2][2];
#pragma unroll
        for (int bj = 0; bj < 2; ++bj)
#pragma unroll
            for (int n = 0; n < 2; ++n) bv[bj][n] = bias ? *(const f32x4*)(bias + bcol0 + bj * HALF + 4 * n) : (f32x4){0.f, 0.f, 0.f, 0.f};
#pragma unroll
        for (int ai = 0; ai < 2; ++ai)
#pragma unroll
            for (int m = 0; m < 4; ++m) { bf16_t* rowp = base + (size_t)(row0 + ai * HALF + m * 16) * ldc + col0;
#pragma unroll
                for (int bj = 0; bj < 2; ++bj) { f32x4 v0 = acc[ai][bj][m][0] + bv[bj][0], v1 = acc[ai][bj][m][1] + bv[bj][1];
                    if (ACT == 1) { f32x2 a = gelu_pk((f32x2){v0[0], v0[1]}), b = gelu_pk((f32x2){v0[2], v0[3]}), c = gelu_pk((f32x2){v1[0], v1[1]}), d = gelu_pk((f32x2){v1[2], v1[3]});
                        v0 = (f32x4){a.x, a.y, b.x, b.y}; v1 = (f32x4){c.x, c.y, d.x, d.y}; }
                    v0 = v0 * sc; v1 = v1 * sc; u32x4 w; w.x = cvt_pk_bf16(v0[0], v0[1]); w.y = cvt_pk_bf16(v0[2], v0[3]); w.z = cvt_pk_bf16(v1[0], v1[1]); w.w = cvt_pk_bf16(v1[2], v1[3]);
                    *(u32x4*)(rowp + bj * HALF) = w; } }
    }
};

template <class Epi, class Sched, bool ALIGN_EPI = false, bool SP2 = false>
__device__ __forceinline__ void gemm_phase(PG8_LAS unsigned char* lds, const Gemm g, const Sched& S, const Epi& E, int wid_s) {
    unsigned z_ = 0u; asm volatile("" : "+v"(z_)); const int tid = wid_s * 64 + (int)__builtin_amdgcn_mbcnt_hi(~0u, __builtin_amdgcn_mbcnt_lo(~0u, z_));
    const int wid = __builtin_amdgcn_readfirstlane(tid >> 6), lane = tid & 63, wr = wid >> 2, wc = wid & 3, fr = lane & 15, fq = lane >> 4;
    int K = g.K; asm volatile("" : "+s"(K));
    const int nt = K / BK;
    unsigned voffA[2], voffB[2];
#pragma unroll
    for (int i = 0; i < 2; ++i) { int R, C; stage_rc(tid * 16 + i * 8192, R, C); const int Rb = Epi::PERM ? ((R & ~31) + perm32(R & 31)) : R;
        voffA[i] = (unsigned)(R * g.lda + C) * 2u; voffB[i] = (unsigned)(Rb * g.ldb + C) * 2u; }
    const size_t kstep = (size_t)(BK * 2);
    const size_t hstepA = (size_t)HALF * g.lda * 2, hstepB = (size_t)HALF * g.ldb * 2;
    const size_t tstepA = 2 * hstepA, tstepB = 2 * hstepB;
    const unsigned ldsw = (unsigned)wid * 1024u;
    const int aoff = lds_byte(wr * 64 + fr, fq * 8), boff = lds_byte(wc * 32 + fr, fq * 8);
#define PG8_SA(b, h) (((b) * 2 + (h)) * HTB)
#define PG8_SB(b, h) ((4 + (b) * 2 + (h)) * HTB)
#define PG8_STAGE(bufoff, gbase, voff) do { _Pragma("unroll") for (int _i = 0; _i < 2; ++_i) \
        __builtin_amdgcn_global_load_lds((const unsigned*)((const char*)(gbase) + (voff)[_i]), (PG8_LAS unsigned*)(lds + (bufoff) + ldsw + _i * 8192), 16, 0, 0); } while (0)
#define PG8_LDA(dst, b, h) do { _Pragma("unroll") for (int m = 0; m < 4; ++m) _Pragma("unroll") for (int k = 0; k < 2; ++k) dst[m][k] = *(const PG8_LAS bf16x8*)(lds + PG8_SA(b, h) + aoff + m * 2048 + k * 1024); } while (0)
#define PG8_LDB(dst, b, h) do { _Pragma("unroll") for (int n = 0; n < 2; ++n) _Pragma("unroll") for (int k = 0; k < 2; ++k) dst[n][k] = *(const PG8_LAS bf16x8*)(lds + PG8_SB(b, h) + boff + n * 2048 + k * 1024); } while (0)
#define PG8_MMA(ai, bj, At, Bt) do { __builtin_amdgcn_s_setprio(1); _Pragma("unroll") for (int m = 0; m < 4; ++m) _Pragma("unroll") for (int n = 0; n < 2; ++n) _Pragma("unroll") for (int k = 0; k < 2; ++k) \
        acc[ai][bj][m][n] = __builtin_amdgcn_mfma_f32_16x16x32_bf16(Bt[n][k], At[m][k], acc[ai][bj][m][n], 0, 0, 0); __builtin_amdgcn_s_setprio(0); } while (0)
#define PG8_WAIT_V(n) asm volatile("s_waitcnt vmcnt(" #n ")" ::: "memory")
#define PG8_WAIT_L(n) asm volatile("s_waitcnt lgkmcnt(" #n ")" ::: "memory")
#define PG8_BAR __builtin_amdgcn_s_barrier()
#define PG8_SCHED __builtin_amdgcn_sched_barrier(0)
    Unit cur, nxt; int ui = 0;
    if (!S.next(0, cur)) return;
    f32x4 acc[2][2][4][2];
#pragma unroll
    for (int a = 0; a < 2; ++a)
#pragma unroll
        for (int b = 0; b < 2; ++b)
#pragma unroll
            for (int m = 0; m < 4; ++m)
#pragma unroll
                for (int n = 0; n < 2; ++n) acc[a][b][m][n] = (f32x4){0.f, 0.f, 0.f, 0.f};
    bf16x8 At[4][2], B0[2][2], B1[2][2];
    const char* cA = (const char*)g.A + (size_t)cur.pm * tstepA + (size_t)cur.koff * 2; const char* cB = (const char*)g.Bt + (size_t)cur.pn * tstepB + (size_t)cur.koff * 2;
    S.a_ready(cur);
    if constexpr (SP2) {
        PG8_STAGE(PG8_SB(0, 0), cB, voffB); PG8_STAGE(PG8_SB(0, 1), cB + hstepB, voffB); PG8_STAGE(PG8_SA(0, 0), cA, voffA); PG8_STAGE(PG8_SA(0, 1), cA + hstepA, voffA);
        if (wr == 1) PG8_BAR;
        PG8_WAIT_V(2); PG8_BAR;
        PG8_STAGE(PG8_SB(1, 0), cB + kstep, voffB); PG8_STAGE(PG8_SA(1, 0), cA + kstep, voffA); PG8_STAGE(PG8_SB(1, 1), cB + hstepB + kstep, voffB);
        PG8_WAIT_V(6); PG8_BAR;
    } else {
        PG8_STAGE(PG8_SB(0, 0), cB, voffB); PG8_STAGE(PG8_SA(0, 0), cA, voffA); PG8_STAGE(PG8_SB(0, 1), cB + hstepB, voffB); PG8_STAGE(PG8_SA(0, 1), cA + hstepA, voffA);
        if (wr == 1) PG8_BAR;
        PG8_WAIT_V(4); PG8_BAR;
        PG8_STAGE(PG8_SB(1, 0), cB + kstep, voffB); PG8_STAGE(PG8_SA(1, 0), cA + kstep, voffA); PG8_STAGE(PG8_SB(1, 1), cB + hstepB + kstep, voffB);
        PG8_WAIT_V(6); PG8_BAR;
    }
    for (;;) {
        const bool has_next = S.next(ui + 1, nxt);
        const char* nA = has_next ? (const char*)g.A + (size_t)nxt.pm * tstepA + (size_t)nxt.koff * 2 : cA; const char* nB = has_next ? (const char*)g.Bt + (size_t)nxt.pn * tstepB + (size_t)nxt.koff * 2 : cB;
        const int ntc = cur.nt ? cur.nt : nt;
        for (int t = 0; t < ntc; t += 2) {
            const bool last = (t == ntc - 2);
            const char* a1 = cA + (size_t)(t + 1) * kstep;
            const char* a2 = last ? nA : cA + (size_t)(t + 2) * kstep; const char* b2 = last ? nB : cB + (size_t)(t + 2) * kstep;
            const char* a3 = a2 + kstep; const char* b3 = b2 + kstep;
            if (last && has_next) S.a_ready(nxt);
            if constexpr (SP2) {
            PG8_LDB(B0, 0, 0); PG8_LDB(B1, 0, 1); PG8_SCHED; PG8_LDA(At, 0, 0); PG8_STAGE(PG8_SA(1, 1), a1 + hstepA, voffA);
            PG8_WAIT_V(8); PG8_WAIT_L(0); PG8_BAR; PG8_MMA(0, 0, At, B0); PG8_MMA(0, 1, At, B1); PG8_BAR; PG8_SCHED;
            PG8_LDA(At, 0, 1); PG8_STAGE(PG8_SB(0, 0), b2, voffB); PG8_STAGE(PG8_SB(0, 1), b2 + hstepB, voffB); PG8_STAGE(PG8_SA(0, 0), a2, voffA);
            PG8_WAIT_V(8); PG8_WAIT_L(0); PG8_BAR; PG8_MMA(1, 0, At, B0); PG8_MMA(1, 1, At, B1); PG8_BAR; PG8_SCHED;
            PG8_LDB(B0, 1, 0); PG8_LDB(B1, 1, 1); PG8_SCHED; PG8_LDA(At, 1, 0); PG8_STAGE(PG8_SA(0, 1), a2 + hstepA, voffA);
            PG8_WAIT_V(8); PG8_WAIT_L(0); PG8_BAR; PG8_MMA(0, 0, At, B0); PG8_MMA(0, 1, At, B1); PG8_BAR; PG8_SCHED;
            PG8_LDA(At, 1, 1); PG8_STAGE(PG8_SB(1, 0), b3, voffB); PG8_STAGE(PG8_SB(1, 1), b3 + hstepB, voffB); PG8_STAGE(PG8_SA(1, 0), a3, voffA);
            PG8_WAIT_V(8); PG8_WAIT_L(0); PG8_BAR; PG8_MMA(1, 0, At, B0); PG8_MMA(1, 1, At, B1); PG8_BAR; PG8_SCHED;
            } else {
            PG8_LDB(B0, 0, 0); PG8_SCHED; PG8_LDA(At, 0, 0); PG8_STAGE(PG8_SA(1, 1), a1 + hstepA, voffA);
            PG8_WAIT_L(8); PG8_BAR; PG8_WAIT_L(0); PG8_MMA(0, 0, At, B0); PG8_BAR; PG8_SCHED;
            PG8_LDB(B1, 0, 1); PG8_STAGE(PG8_SB(0, 0), b2, voffB);
            PG8_BAR; PG8_WAIT_L(0); PG8_MMA(0, 1, At, B1); PG8_BAR;
            PG8_LDA(At, 0, 1); PG8_STAGE(PG8_SA(0, 0), a2, voffA);
            PG8_BAR; PG8_WAIT_L(0); PG8_MMA(1, 0, At, B0); PG8_BAR; PG8_SCHED;
            PG8_STAGE(PG8_SB(0, 1), b2 + hstepB, voffB);
            PG8_WAIT_V(6); PG8_BAR; PG8_MMA(1, 1, At, B1); PG8_BAR;
            PG8_LDB(B0, 1, 0); PG8_SCHED; PG8_LDA(At, 1, 0); PG8_STAGE(PG8_SA(0, 1), a2 + hstepA, voffA);
            PG8_WAIT_L(8); PG8_BAR; PG8_WAIT_L(0); PG8_MMA(0, 0, At, B0); PG8_BAR; PG8_SCHED;
            PG8_LDB(B1, 1, 1); PG8_STAGE(PG8_SB(1, 0), b3, voffB);
            PG8_BAR; PG8_WAIT_L(0); PG8_MMA(0, 1, At, B1); PG8_BAR;
            PG8_LDA(At, 1, 1); PG8_STAGE(PG8_SA(1, 0), a3, voffA);
            PG8_BAR; PG8_WAIT_L(0); PG8_MMA(1, 0, At, B0); PG8_BAR; PG8_SCHED;
            PG8_STAGE(PG8_SB(1, 1), b3 + hstepB, voffB);
            PG8_WAIT_V(6); PG8_BAR; PG8_MMA(1, 1, At, B1); PG8_BAR;
            }
        }
        if constexpr (ALIGN_EPI) { if (wr == 0) PG8_BAR; }
        if constexpr (!Epi::AFTER_DRAIN) { E(acc, cur, wr, wc, fr, fq); S.done(cur); }
        if (!has_next) break;
#pragma unroll
        for (int a = 0; a < 2; ++a)
#pragma unroll
            for (int b = 0; b < 2; ++b)
#pragma unroll
                for (int m = 0; m < 4; ++m)
#pragma unroll
                    for (int n = 0; n < 2; ++n) acc[a][b][m][n] = (f32x4){0.f, 0.f, 0.f, 0.f};
        cur = nxt; cA = nA; cB = nB; ++ui;
        if constexpr (ALIGN_EPI) { if (wr == 1) PG8_BAR; }
    }
    PG8_WAIT_V(0);
    if constexpr (!ALIGN_EPI) { if (wr == 0) PG8_BAR; }
    PG8_BAR;
    if constexpr (Epi::AFTER_DRAIN) { E.fused(acc, cur, wr, wc, fr, fq, lds, wid, lane); S.done(cur); }
#undef PG8_SA
#undef PG8_SB
#undef PG8_STAGE
#undef PG8_LDA
#undef PG8_LDB
#undef PG8_MMA
#undef PG8_WAIT_V
#undef PG8_WAIT_L
#undef PG8_BAR
#undef PG8_SCHED
}
}
constexpr int NWAVES = 8;
constexpr int T = 65536, DM = 1024, FF = 2816, NUP = 2 * FF, INC = 5376, SEQ = 4096, NB = 16;
constexpr float EPS = 1e-6f;
constexpr size_t MiB = 1u << 20;
constexpr size_t WS_APOW = 1 * MiB;
constexpr size_t WS_BBAR = 2 * MiB + 512 * 1024;
constexpr size_t WS_KMAT = 3 * MiB;
constexpr size_t WS_W = 5 * MiB, W_LSTRIDE = 93 * MiB;
constexpr size_t WO_UP1 = 0, WO_DN1 = 11 * MiB, WO_IN = 16 * MiB + 512 * 1024, WO_GLU = 27 * MiB, WO_BR = 27 * MiB + 256 * 1024, WO_OUT = 29 * MiB + 256 * 1024,
                 WO_UP2 = 31 * MiB + 256 * 1024, WO_DN2 = 42 * MiB + 256 * 1024, WO_BS5 = 47 * MiB + 768 * 1024;
constexpr size_t WS_XN = 192 * MiB;
constexpr size_t WS_H = 320 * MiB;
constexpr size_t WS_G = 320 * MiB;
constexpr size_t WS_Q = 704 * MiB, WS_K = 768 * MiB, WS_V = 832 * MiB;
constexpr size_t WS_MG = 704 * MiB;
constexpr size_t WS_AS5 = 896 * MiB;
constexpr size_t WS_ZG = 932 * MiB;
constexpr size_t WS_END = 968 * MiB;
typedef unsigned long long rss_t;
constexpr float RSS_FIX = 16777216.0f, RSS_INV = 1.0f / 16777216.0f;
constexpr size_t WS_RSS = 964 * MiB;
constexpr int LDS_BYTES = 147456;
constexpr int AS5_LD = 1152, BS5_ROWS = 1280;

#define GAS __attribute__((address_space(1)))
#define LAS __attribute__((address_space(3)))
typedef unsigned short bf16;
typedef unsigned v4u __attribute__((ext_vector_type(4)));
typedef unsigned v2u __attribute__((ext_vector_type(2)));
typedef float f32x4 __attribute__((ext_vector_type(4)));
typedef float f32x2 __attribute__((ext_vector_type(2)));
typedef short bf16x8 __attribute__((ext_vector_type(8)));
typedef short s16x4 __attribute__((ext_vector_type(4)));
__device__ __forceinline__ unsigned f2bf(float f) { unsigned u = __builtin_bit_cast(unsigned, f); return (u + 0x7fffu + ((u >> 16) & 1u)) >> 16; }
__device__ __forceinline__ unsigned pk2(float lo, float hi) { return f2bf(lo) | (f2bf(hi) << 16); }
__device__ __forceinline__ float bflo(unsigned w) { return __builtin_bit_cast(float, w << 16); }
__device__ __forceinline__ float bfhi(unsigned w) { return __builtin_bit_cast(float, w & 0xffff0000u); }
__device__ __forceinline__ float fsigmoid(float x) { return __builtin_amdgcn_rcpf(1.0f + __expf(-x)); }
__device__ __forceinline__ float shx(float v, int m, int lane) { return __builtin_bit_cast(float, __builtin_amdgcn_ds_bpermute((lane ^ m) << 2, __builtin_bit_cast(int, v))); }
__device__ __forceinline__ float wave_sum(float v, int lane) {
#pragma unroll
    for (int o = 1; o < 64; o <<= 1) v += shx(v, o, lane);
    return v;
}


#define XB_TMO      128
#define XB_XCNT(j)  (256  + 64 * (j))
#define XB_XSUB(j)  (1280 + 64 * (j))
#define XB_XGEN(j)  (2304 + 64 * (j))
#define XB_TOP      3328
#define XB_TOPGEN   3392
#define XCD_BAR_WORDS 3456
#define XB_SPIN_CAP (1u << 18)

__device__ __forceinline__ unsigned xb_ld(unsigned* p)              { return __hip_atomic_load(p, __ATOMIC_RELAXED, __HIP_MEMORY_SCOPE_AGENT); }
__device__ __forceinline__ unsigned xb_add(unsigned* p, unsigned v) { return __hip_atomic_fetch_add(p, v, __ATOMIC_RELAXED, __HIP_MEMORY_SCOPE_AGENT); }
__device__ __forceinline__ unsigned xb_xcc_id() { return (unsigned)__builtin_amdgcn_s_getreg((3 << 11) | 20) & 0xFu; }
#define XB_SPIN(cond, bar) do { unsigned _sp = 0; while (cond) { __builtin_amdgcn_s_sleep(1); \
    if ((++_sp & 255u) == 0u) { if (xb_ld(&(bar)[XB_TMO])) break; if (_sp > XB_SPIN_CAP) { atomicAdd(&(bar)[XB_TMO], 1u); break; } } } } while (0)

struct XcdBarrier {
    unsigned* bar; unsigned x;
    volatile LAS unsigned* st;
};

__device__ __forceinline__ XcdBarrier xcd_barrier_post(unsigned* bar, volatile LAS unsigned* st, bool leader) {
    XcdBarrier b; b.bar = bar; b.x = xb_xcc_id(); b.st = st;
    if (leader) (void)xb_add(&bar[XB_XCNT(b.x)], 1u);
    return b;
}
__device__ __forceinline__ void xcd_barrier_complete(unsigned* bar, unsigned x, unsigned& nloc, unsigned& nx) {
    const unsigned G = gridDim.x * gridDim.y * gridDim.z;
    unsigned sum, cnt, mine, sp = 0u;
    for (;;) {
        sum = 0u; cnt = 0u; mine = 0u;
#pragma unroll
        for (unsigned j = 0; j < 16; ++j) { const unsigned c = xb_ld(&bar[XB_XCNT(j)]); sum += c; cnt += (c > 0u) ? 1u : 0u; mine = (j == x) ? c : mine; }
        if (sum == G) break;
        __builtin_amdgcn_s_sleep(1);
        if ((++sp & 255u) == 0u) { if (xb_ld(&bar[XB_TMO])) break; if (sp > XB_SPIN_CAP) { atomicAdd(&bar[XB_TMO], 1u); break; } }
    }
    nloc = mine > 0u ? mine : 1u; nx = cnt > 0u ? cnt : 1u;
}

__device__ __forceinline__ void xcd_barrier(const XcdBarrier& b, bool leader) {
    asm volatile("s_waitcnt vmcnt(0)" ::: "memory");
    __syncthreads();
    if (leader) {
        unsigned* bar = b.bar;
        __builtin_amdgcn_s_waitcnt(0);
        unsigned nloc = b.st[0], nx = b.st[1];
        if (nloc == 0u) { xcd_barrier_complete(bar, b.x, nloc, nx); b.st[0] = nloc; b.st[1] = nx; }
        const unsigned old = xb_add(&bar[XB_XSUB(b.x)], 1u);
        const unsigned gen = old / nloc;
        if (old + 1u == (gen + 1u) * nloc) {
            __builtin_amdgcn_fence(__ATOMIC_RELEASE, "agent");
            asm volatile("s_waitcnt vmcnt(0)" ::: "memory");
            const unsigned og = xb_add(&bar[XB_TOP], 1u);
            const unsigned tg = og / nx;
            if (og + 1u == (tg + 1u) * nx) xb_add(&bar[XB_TOPGEN], 1u);
            else XB_SPIN(xb_ld(&bar[XB_TOPGEN]) == tg, bar);
            __builtin_amdgcn_fence(__ATOMIC_ACQUIRE, "agent");
            xb_add(&bar[XB_XGEN(b.x)], 1u);
            asm volatile("s_waitcnt vmcnt(0)" ::: "memory");
        } else {
            XB_SPIN(xb_ld(&bar[XB_XGEN(b.x)]) == gen, bar);
            __builtin_amdgcn_fence(__ATOMIC_ACQUIRE, "agent");
            asm volatile("s_waitcnt vmcnt(0)" ::: "memory");
        }
    }
    __syncthreads();
}

struct Args { const float* in[30]; float* out; unsigned char* ws; };
typedef const Args __attribute__((address_space(4)))* KArgs;
__device__ __forceinline__ KArgs kargs() { auto p = __builtin_amdgcn_kernarg_segment_ptr(); asm volatile("" : "+s"(p)); return (KArgs)p; }
using pg8::Unit; using pg8::cvt_pk_bf16;
template <int ACT> struct EpiGlu {
    static constexpr bool PERM = true, AFTER_DRAIN = false;
    bf16* O; int ldc; int col_off; int rssi;
    __device__ __forceinline__ void operator()(const f32x4 (&acc)[2][2][4][2], const Unit& u, int wr, int wc, int fr, int fq) const {
        const rss_t* rss = rssi >= 0 ? (const rss_t*)(kargs()->ws + WS_RSS) + (size_t)rssi * T : nullptr;
        const int row0 = u.pm * 256 + wr * 64 + fr; const int col0 = col_off + u.pn * 128 + wc * 16 + 4 * fq;
#pragma unroll
        for (int ai = 0; ai < 2; ++ai)
#pragma unroll
            for (int m = 0; m < 4; ++m) { const int row = row0 + ai * 128 + m * 16; bf16* rowp = O + (size_t)row * ldc + col0;
                const float rs = rss ? __builtin_amdgcn_rsqf((float)rss[row] * (RSS_INV / DM) + EPS) : 1.f;
#pragma unroll
                for (int bj = 0; bj < 2; ++bj) { const f32x4 a = acc[ai][bj][m][0] * rs, b = acc[ai][bj][m][1] * rs; f32x4 r;
#pragma unroll
                    for (int i = 0; i < 4; ++i) r[i] = (ACT == 0) ? a[i] * fsigmoid(a[i]) * b[i] : a[i] * fsigmoid(b[i]);
                    v2u w; w.x = cvt_pk_bf16(r[0], r[1]); w.y = cvt_pk_bf16(r[2], r[3]); *(v2u*)(rowp + bj * 64) = w; } }
    }
};
struct EpiSwiGlu {
    static constexpr bool PERM = true, AFTER_DRAIN = false;
    bf16* O; int ldc; int rssi;
    __device__ __forceinline__ void operator()(const f32x4 (&acc)[2][2][4][2], const Unit& u, int wr, int wc, int fr, int fq) const {
        const rss_t* rss = (const rss_t*)(kargs()->ws + WS_RSS) + (size_t)rssi * T;
        const int row0 = u.pm * 256 + wr * 64 + fr; const int col0 = u.pn * 128 + wc * 32 + 8 * fq;
#pragma unroll
        for (int ai = 0; ai < 2; ++ai)
#pragma unroll
            for (int m = 0; m < 4; ++m) { const int row = row0 + ai * 128 + m * 16;
                const float rs = __builtin_amdgcn_rsqf((float)rss[row] * (RSS_INV / DM) + EPS); const float rs2 = rs * rs, rsl = rs * -1.44269504089f;
                float r[8];
#pragma unroll
                for (int n = 0; n < 2; ++n) { const f32x4 a = acc[ai][0][m][n], b = acc[ai][1][m][n];
#pragma unroll
                    for (int i = 0; i < 4; ++i) r[4 * n + i] = (a[i] * b[i]) * rs2 * __builtin_amdgcn_rcpf(1.0f + __builtin_amdgcn_exp2f(a[i] * rsl)); }
                v4u w; w.x = cvt_pk_bf16(r[0], r[1]); w.y = cvt_pk_bf16(r[2], r[3]); w.z = cvt_pk_bf16(r[4], r[5]); w.w = cvt_pk_bf16(r[6], r[7]);
                *(v4u*)(O + (size_t)row * ldc + col0) = w; }
    }
};
struct EpiResid {
    static constexpr bool PERM = true, AFTER_DRAIN = false;
    int final_out; float s; int rssi;
    __device__ __forceinline__ void operator()(const f32x4 (&acc)[2][2][4][2], const Unit& u, int wr, int wc, int fr, int fq) const {
        KArgs ka = kargs(); bf16* xb = (bf16*)(ka->ws + WS_XN); float* xout = ka->out;
        rss_t* rss = (rss_t*)(ka->ws + WS_RSS) + (size_t)(rssi < 0 ? 0 : rssi) * T; const bool emit = rssi >= 0;
        const int row0 = u.pm * 256 + wr * 64 + fr; const int col0 = u.pn * 256 + wc * 32 + 8 * fq; const int lane = fq * 16 + fr;
#pragma unroll
        for (int ai = 0; ai < 2; ++ai)
#pragma unroll
            for (int m = 0; m < 4; ++m) { const int row = row0 + ai * 128 + m * 16; const size_t off = (size_t)row * DM + col0; float ss = 0.f;
#pragma unroll
                for (int bj = 0; bj < 2; ++bj) { const v4u xv = *(const v4u*)(xb + off + bj * 128);
                    const f32x4 y0 = (f32x4){bflo(xv.x), bfhi(xv.x), bflo(xv.y), bfhi(xv.y)} + acc[ai][bj][m][0] * s, y1 = (f32x4){bflo(xv.z), bfhi(xv.z), bflo(xv.w), bfhi(xv.w)} + acc[ai][bj][m][1] * s;
                    ss += ((y0.x * y0.x + y0.y * y0.y) + (y0.z * y0.z + y0.w * y0.w)) + ((y1.x * y1.x + y1.y * y1.y) + (y1.z * y1.z + y1.w * y1.w));
                    if (final_out) { *(f32x4*)(xout + off + bj * 128) = y0; *(f32x4*)(xout + off + bj * 128 + 4) = y1; }
                    else { v4u w; w.x = cvt_pk_bf16(y0.x, y0.y); w.y = cvt_pk_bf16(y0.z, y0.w); w.z = cvt_pk_bf16(y1.x, y1.y); w.w = cvt_pk_bf16(y1.z, y1.w); *(v4u*)(xb + off + bj * 128) = w; } }
                if (emit) { ss += shx(ss, 16, lane); ss += shx(ss, 32, lane); if (fq == 0) (void)__hip_atomic_fetch_add(rss + row, (rss_t)(ss * RSS_FIX), __ATOMIC_RELAXED, __HIP_MEMORY_SCOPE_AGENT); } }
    }
};
struct EpiIn {
    static constexpr bool PERM = true, AFTER_DRAIN = false;
    bf16 *AS5, *Q  , *ZG; unsigned char* G8; int rssi; const float* bgate;
    __device__ __forceinline__ void operator()(const f32x4 (&acc)[2][2][4][2], const Unit& u, int wr, int wc, int fr, int fq) const {
        const int row0 = u.pm * 256 + wr * 64 + fr; const int pn = u.pn; const int cl0 = wc * 32 + 8 * fq;
        const rss_t* rss = (const rss_t*)(kargs()->ws + WS_RSS) + (size_t)rssi * T;
        f32x4 bv[2][2];
        { const int ct = (pn >= 9 ? (pn - 9) * 256 : 0) + cl0;
#pragma unroll
          for (int bj = 0; bj < 2; ++bj)
#pragma unroll
            for (int n = 0; n < 2; ++n) bv[bj][n] = *(const f32x4*)(bgate + ct + bj * 128 + 4 * n); }
        float rsv[2][4];
#pragma unroll
        for (int ai = 0; ai < 2; ++ai)
#pragma unroll
            for (int m = 0; m < 4; ++m) rsv[ai][m] = __builtin_amdgcn_rsqf((float)rss[row0 + ai * 128 + m * 16] * (RSS_INV / DM) + EPS);
        if (pn == 0) {
#pragma unroll
            for (int ai = 0; ai < 2; ++ai)
#pragma unroll
                for (int m = 0; m < 4; ++m) { const float rs = rsv[ai][m]; const int t = row0 + ai * 128 + m * 16; const int b = t >> 12, c = (t >> 6) & 63, j = t & 63;
#pragma unroll
                    for (int bj = 0; bj < 2; ++bj) { const int col = cl0 + bj * 128; const int g = col >> 4, ci0 = col & 15;
                        const f32x4 v0 = (acc[ai][bj][m][0] * rs), v1 = (acc[ai][bj][m][1] * rs); v4u w; w.x = cvt_pk_bf16(v0[0], v0[1]); w.y = cvt_pk_bf16(v0[2], v0[3]); w.z = cvt_pk_bf16(v1[0], v1[1]); w.w = cvt_pk_bf16(v1[2], v1[3]);
                        *(v4u*)(AS5 + ((size_t)(g * 1024 + b * 64 + c) * AS5_LD + j * 16 + ci0)) = w; } }
        } else if (pn <= 6) {
            bf16* base = Q + (size_t)((pn - 1) >> 1) * ((size_t)T * 512); const int colt = ((pn - 1) & 1) * 256 + cl0;
#pragma unroll
            for (int ai = 0; ai < 2; ++ai)
#pragma unroll
                for (int m = 0; m < 4; ++m) { const float rs = rsv[ai][m]; bf16* rowp = base + (size_t)(row0 + ai * 128 + m * 16) * 512 + colt;
#pragma unroll
                    for (int bj = 0; bj < 2; ++bj) { const f32x4 v0 = (acc[ai][bj][m][0] * rs), v1 = (acc[ai][bj][m][1] * rs); v4u w; w.x = cvt_pk_bf16(v0[0], v0[1]); w.y = cvt_pk_bf16(v0[2], v0[3]); w.z = cvt_pk_bf16(v1[0], v1[1]); w.w = cvt_pk_bf16(v1[2], v1[3]);
                        *(v4u*)(rowp + bj * 128) = w; } }
        } else if (pn <= 8) {
            const int col0 = (pn - 7) * 128 + wc * 16 + 4 * fq;
#pragma unroll
            for (int ai = 0; ai < 2; ++ai)
#pragma unroll
                for (int m = 0; m < 4; ++m) { const float rs = rsv[ai][m]; bf16* rowp = ZG + (size_t)(row0 + ai * 128 + m * 16) * 256 + col0;
#pragma unroll
                    for (int bj = 0; bj < 2; ++bj) { const f32x4 a = (acc[ai][bj][m][0] * rs), b = (acc[ai][bj][m][1] * rs); f32x4 r;
#pragma unroll
                        for (int i = 0; i < 4; ++i) r[i] = a[i] * fsigmoid(b[i]);
                        v2u w; w.x = cvt_pk_bf16(r[0], r[1]); w.y = cvt_pk_bf16(r[2], r[3]); *(v2u*)(rowp + bj * 64) = w; } }
        } else {
            const int colt = (pn - 9) * 256 + cl0;
#pragma unroll
            for (int ai = 0; ai < 2; ++ai)
#pragma unroll
                for (int m = 0; m < 4; ++m) { const float rs = rsv[ai][m]; unsigned char* rowp = G8 + (size_t)(row0 + ai * 128 + m * 16) * 3072 + colt;
#pragma unroll
                    for (int bj = 0; bj < 2; ++bj) { const f32x4 v0 = (acc[ai][bj][m][0] * rs) + bv[bj][0], v1 = (acc[ai][bj][m][1] * rs) + bv[bj][1]; v2u w; w.x = 0u; w.y = 0u;
#pragma unroll
                        for (int i = 0; i < 4; ++i) { w.x = __builtin_amdgcn_cvt_pk_u8_f32(fsigmoid(v0[i]) * 255.0f, i, w.x); w.y = __builtin_amdgcn_cvt_pk_u8_f32(fsigmoid(v1[i]) * 255.0f, i, w.y); }
                        *(v2u*)(rowp + bj * 128) = w; } }
        }
    }
};
template <bool FIRST> struct EpiBranch {
    static constexpr bool PERM = true, AFTER_DRAIN = false;
    const bf16* G; bf16* MG; int br; const float* bgate;
    __device__ __forceinline__ void operator()(const f32x4 (&acc)[2][2][4][2], const Unit& u, int wr, int wc, int fr, int fq) const {
        const int row0 = u.pm * 256 + wr * 64 + fr; const int col0 = u.pn * 256 + wc * 32 + 8 * fq;
        f32x4 bv[2][2];
#pragma unroll
        for (int bj = 0; bj < 2; ++bj)
#pragma unroll
            for (int n = 0; n < 2; ++n) bv[bj][n] = *(const f32x4*)(bgate + br * 1024 + col0 + bj * 128 + 4 * n);
#pragma unroll
        for (int ai = 0; ai < 2; ++ai)
#pragma unroll
            for (int m = 0; m < 4; ++m) { const size_t r = (size_t)(row0 + ai * 128 + m * 16);
#pragma unroll
                for (int bj = 0; bj < 2; ++bj) { const v4u gw = *(const v4u*)(G + r * 3072 + br * 1024 + col0 + bj * 128); bf16* mp = MG + r * DM + col0 + bj * 128;
                    const f32x4 a0 = acc[ai][bj][m][0], a1 = acc[ai][bj][m][1]; const f32x4 b0 = bv[bj][0], b1 = bv[bj][1];
                    float o[8] = {a0[0] * fsigmoid(bflo(gw.x) + b0[0]), a0[1] * fsigmoid(bfhi(gw.x) + b0[1]), a0[2] * fsigmoid(bflo(gw.y) + b0[2]), a0[3] * fsigmoid(bfhi(gw.y) + b0[3]),
                                  a1[0] * fsigmoid(bflo(gw.z) + b1[0]), a1[1] * fsigmoid(bfhi(gw.z) + b1[1]), a1[2] * fsigmoid(bflo(gw.w) + b1[2]), a1[3] * fsigmoid(bfhi(gw.w) + b1[3])};
                    if (!FIRST) { const v4u pw = *(const v4u*)mp; o[0] += bflo(pw.x); o[1] += bfhi(pw.x); o[2] += bflo(pw.y); o[3] += bfhi(pw.y); o[4] += bflo(pw.z); o[5] += bfhi(pw.z); o[6] += bflo(pw.w); o[7] += bfhi(pw.w); }
                    v4u w; w.x = cvt_pk_bf16(o[0], o[1]); w.y = cvt_pk_bf16(o[2], o[3]); w.z = cvt_pk_bf16(o[4], o[5]); w.w = cvt_pk_bf16(o[6], o[7]); *(v4u*)mp = w; } }
    }
};
struct EpiBranchSeg {
    static constexpr bool PERM = true, AFTER_DRAIN = false;
    const unsigned char* G8; bf16* MG;
    __device__ __forceinline__ void operator()(const f32x4 (&acc)[2][2][4][2], const Unit& u, int wr, int wc, int fr, int fq) const {
        const int br = u.seg; const int row0 = u.pm * 256 + wr * 64 + fr; const int col0 = u.pn * 256 + wc * 32 + 8 * fq; const float k255 = 1.0f / 255.0f;
#pragma unroll
        for (int ai = 0; ai < 2; ++ai)
#pragma unroll
            for (int m = 0; m < 4; ++m) { const size_t r = (size_t)(row0 + ai * 128 + m * 16);
#pragma unroll
                for (int bj = 0; bj < 2; ++bj) { const v2u gw = *(const v2u*)(G8 + r * 3072 + br * 1024 + col0 + bj * 128); bf16* mp = MG + r * DM + col0 + bj * 128;
                    const f32x4 a0 = acc[ai][bj][m][0] * k255, a1 = acc[ai][bj][m][1] * k255;
                    float o[8] = {a0[0] * (float)(gw.x & 0xffu), a0[1] * (float)((gw.x >> 8) & 0xffu), a0[2] * (float)((gw.x >> 16) & 0xffu), a0[3] * (float)(gw.x >> 24),
                                  a1[0] * (float)(gw.y & 0xffu), a1[1] * (float)((gw.y >> 8) & 0xffu), a1[2] * (float)((gw.y >> 16) & 0xffu), a1[3] * (float)(gw.y >> 24)};
                    if (br != 0) { const v4u pw = *(const v4u*)mp; o[0] += bflo(pw.x); o[1] += bfhi(pw.x); o[2] += bflo(pw.y); o[3] += bfhi(pw.y); o[4] += bflo(pw.z); o[5] += bfhi(pw.z); o[6] += bflo(pw.w); o[7] += bfhi(pw.w); }
                    v4u w; w.x = cvt_pk_bf16(o[0], o[1]); w.y = cvt_pk_bf16(o[2], o[3]); w.z = cvt_pk_bf16(o[4], o[5]); w.w = cvt_pk_bf16(o[6], o[7]); *(v4u*)mp = w; } }
    }
};
struct BranchOrder { pg8::StaticOrder base;
    __device__ __forceinline__ bool next(int i, Unit& u) const { const int ti = i / 3, br = i - 3 * ti; if (!base.next(ti, u)) return false; u.seg = br; u.koff = br == 0 ? 0 : (br == 1 ? 256 : 768); u.nt = br == 1 ? 8 : 4; return true; }
    __device__ __forceinline__ void a_ready(const Unit&) const {} __device__ __forceinline__ void done(const Unit&) const {} };
struct EpiS5Y {
    static constexpr bool PERM = true, AFTER_DRAIN = false;
    bf16* S5G;
    __device__ __forceinline__ void operator()(const f32x4 (&acc)[2][2][4][2], const Unit& u, int wr, int wc, int fr, int fq) const {
        const int g = u.pm >> 2, rb = u.pm & 3, nb = u.pn - 5 * g;
        const int r0 = rb * 256 + wr * 64 + fr;
#pragma unroll
        for (int ai = 0; ai < 2; ++ai)
#pragma unroll
            for (int m = 0; m < 4; ++m) { const int r = r0 + ai * 128 + m * 16; const int b = r >> 6, c = r & 63;
#pragma unroll
                for (int bj = 0; bj < 2; ++bj) { const int col = nb * 256 + bj * 128 + wc * 32 + 8 * fq; const int i = col >> 4, co0 = col & 15;
                    const f32x4 v0 = acc[ai][bj][m][0], v1 = acc[ai][bj][m][1]; float o[8] = {v0[0], v0[1], v0[2], v0[3], v1[0], v1[1], v1[2], v1[3]};
#pragma unroll
                    for (int q = 0; q < 8; ++q) { const float x = o[q]; o[q] = x * fsigmoid(1.5957691216f * (x + 0.044715f * x * x * x)); }
                    v4u w; w.x = cvt_pk_bf16(o[0], o[1]); w.y = cvt_pk_bf16(o[2], o[3]); w.z = cvt_pk_bf16(o[4], o[5]); w.w = cvt_pk_bf16(o[6], o[7]);
                    *(v4u*)(S5G + ((size_t)(b * SEQ + c * 64 + i) * 256 + g * 16 + co0)) = w; } }
    }
};
struct EpiS5State {
    static constexpr bool PERM = false, AFTER_DRAIN = true;
    bf16* AS5; const f32x2* apow;
    __device__ __forceinline__ void operator()(const f32x4 (&)[2][2][4][2], const Unit&, int, int, int, int) const {}
    __device__ __forceinline__ void fused(f32x4 (&acc)[2][2][4][2], const Unit& u, int wr, int wc, int fr, int fq, PG8_LAS unsigned char* lds, int wid, int lane) const {
        PG8_LAS float* S = (PG8_LAS float*)lds;
        const int g = u.pm >> 2, rb = u.pm & 3;
#pragma unroll
        for (int ai = 0; ai < 2; ++ai)
#pragma unroll
            for (int m = 0; m < 4; ++m)
#pragma unroll
                for (int n = 0; n < 2; ++n) { const int r = ai * 128 + wr * 64 + m * 16 + fr; const int c = wc * 32 + n * 16 + 4 * fq; *(PG8_LAS f32x4*)(S + r * 132 + c) = acc[ai][0][m][n]; }
        asm volatile("s_waitcnt lgkmcnt(0)" ::: "memory"); __builtin_amdgcn_s_barrier(); asm volatile("" ::: "memory");
        const int tid = wid * 64 + lane;
        if (tid < 256) {
            const int bl = tid >> 6, p = tid & 63; const f32x2 a64 = apow[(g * 65 + 64) * 64 + p];
            float xr = 0.f, xi = 0.f; bf16* dst = AS5 + ((size_t)(g * 1024 + rb * 256 + bl * 64) * AS5_LD + 1024 + 2 * p);
            for (int c = 0; c < 64; ++c) { const f32x2 s = *(PG8_LAS f32x2*)(S + (bl * 64 + c) * 132 + 2 * p);
                *(unsigned*)(dst + (size_t)c * AS5_LD) = pk2(xr, xi);
                const float nr = a64.x * xr - a64.y * xi + s.x, ni = a64.x * xi + a64.y * xr + s.y; xr = nr; xi = ni; }
        }
    }
};
struct S5Order1 { int G, c; __device__ bool next(int i, Unit& u) const { const int L = i * G + c; if (L >= 64) return false; const int g = L >> 2, rb = L & 3; u.pm = g * 4 + rb; u.pn = g * 5 + 4; return true; }
    __device__ __forceinline__ void a_ready(const Unit&) const {} __device__ __forceinline__ void done(const Unit&) const {} };
struct S5Order2 { int G, c; __device__ bool next(int i, Unit& u) const { const int L = i * G + c; if (L >= 256) return false; const int g = L >> 4, rb = (L >> 2) & 3, nb = L & 3; u.pm = g * 4 + rb; u.pn = g * 5 + nb; return true; }
    __device__ __forceinline__ void a_ready(const Unit&) const {} __device__ __forceinline__ void done(const Unit&) const {} };

__device__ __forceinline__ void p0_transpose_item(const float* W, int ldw, int srcoff, int mode, int Hh, int Nsub, bf16* WT, int row_off, int ldt, int koff, LAS float* scr, int item, int lane, const float* gain = nullptr) {
    const int nblk = Nsub / 32, kb = item / nblk, nb = item % nblk, k0 = 64 * kb, n0 = 32 * nb;
    const int nn = n0 + (lane & 31); const int sc = srcoff + (mode == 1 ? (((nn & 7) >> 2) * Hh + (nn >> 3) * 4 + (nn & 3)) : mode == 2 ? ((((nn & 255) >> 7) * Hh) + (nn >> 8) * 128 + (nn & 127)) : nn);
    float wv[32];
#pragma unroll
    for (int i = 0; i < 32; ++i) wv[i] = W[(size_t)(k0 + 2 * i + (lane >> 5)) * ldw + sc];
    if (gain) {
#pragma unroll
        for (int i = 0; i < 32; ++i) wv[i] *= gain[k0 + 2 * i + (lane >> 5)]; }
#pragma unroll
    for (int i = 0; i < 32; ++i) scr[(2 * i + (lane >> 5)) * 33 + (lane & 31)] = wv[i];
    asm volatile("s_waitcnt lgkmcnt(0)" ::: "memory");
    const int c = lane & 7;
#pragma unroll
    for (int j = 0; j < 4; ++j) { const int n = (lane >> 3) + 8 * j; const LAS float* s = scr + (8 * c) * 33 + n;
        v4u o; o.x = pk2(s[0 * 33], s[1 * 33]); o.y = pk2(s[2 * 33], s[3 * 33]); o.z = pk2(s[4 * 33], s[5 * 33]); o.w = pk2(s[6 * 33], s[7 * 33]);
        *(v4u*)(WT + (size_t)(row_off + n0 + n) * ldt + koff + k0 + 8 * c) = o; }
    asm volatile("s_waitcnt lgkmcnt(0)" ::: "memory");
}
__device__ __forceinline__ void dsincos(double x, double& s, double& c) {
    const double k = __builtin_rint(x * 0.63661977236758134308);
    double r = __builtin_fma(-k, 1.57079632679489655800, x); r = __builtin_fma(-k, 6.12323399573676603587e-17, r);
    const double r2 = r * r;
    double sp = -1.0 / 1307674368000.0; sp = sp * r2 + 1.0 / 6227020800.0; sp = sp * r2 - 1.0 / 39916800.0; sp = sp * r2 + 1.0 / 362880.0; sp = sp * r2 - 1.0 / 5040.0; sp = sp * r2 + 1.0 / 120.0; sp = sp * r2 - 1.0 / 6.0; sp = sp * r2 + 1.0;
    const double sr = sp * r;
    double cp = 1.0 / 20922789888000.0; cp = cp * r2 - 1.0 / 87178291200.0; cp = cp * r2 + 1.0 / 479001600.0; cp = cp * r2 - 1.0 / 3628800.0; cp = cp * r2 + 1.0 / 40320.0; cp = cp * r2 - 1.0 / 720.0; cp = cp * r2 + 1.0 / 24.0; cp = cp * r2 - 0.5; cp = cp * r2 + 1.0;
    const int q = ((int)k) & 3;
    s = (q == 0) ? sr : (q == 1) ? cp : (q == 2) ? -sr : -cp;
    c = (q == 0) ? cp : (q == 1) ? -sr : (q == 2) ? -cp : sr;
}


__device__ __forceinline__ void rawnorm_phase(const float* x, bf16* XB, rss_t* rss, int wid_s) {
    unsigned z_ = 0u; asm volatile("" : "+v"(z_)); const int tid = wid_s * 64 + (int)__builtin_amdgcn_mbcnt_hi(~0u, __builtin_amdgcn_mbcnt_lo(~0u, z_)); const int wid = __builtin_amdgcn_readfirstlane(tid >> 6), lane = tid & 63;
    const int gw = blockIdx.x * NWAVES + wid, NGW = gridDim.x * NWAVES;
    for (int m = gw; m < T; m += 2 * NGW) {
        const int m1 = m + NGW;
        const f32x4* xr0 = (const f32x4*)(x + (size_t)m * DM) + lane; const f32x4* xr1 = (const f32x4*)(x + (size_t)m1 * DM) + lane; f32x4 v0[4], v1[4]; float s0 = 0.f, s1 = 0.f;
#pragma unroll
        for (int j = 0; j < 4; ++j) { v0[j] = xr0[64 * j]; v1[j] = xr1[64 * j]; }
#pragma unroll
        for (int j = 0; j < 4; ++j) { s0 += (v0[j].x * v0[j].x + v0[j].y * v0[j].y) + (v0[j].z * v0[j].z + v0[j].w * v0[j].w); s1 += (v1[j].x * v1[j].x + v1[j].y * v1[j].y) + (v1[j].z * v1[j].z + v1[j].w * v1[j].w); }
        s0 = wave_sum(s0, lane); s1 = wave_sum(s1, lane); if (lane == 0) { rss[m] = (rss_t)(s0 * RSS_FIX); rss[m1] = (rss_t)(s1 * RSS_FIX); }
        v2u* o0 = (v2u*)(XB + (size_t)m * DM) + lane; v2u* o1 = (v2u*)(XB + (size_t)m1 * DM) + lane;
#pragma unroll
        for (int j = 0; j < 4; ++j) { v2u w; w.x = pk2(v0[j].x, v0[j].y); w.y = pk2(v0[j].z, v0[j].w); o0[64 * j] = w; w.x = pk2(v1[j].x, v1[j].y); w.y = pk2(v1[j].z, v1[j].w); o1[64 * j] = w; }
    }
}

#define DPPF(v, ctrl) __builtin_bit_cast(float, __builtin_amdgcn_update_dpp(0, __builtin_bit_cast(int, (v)), (ctrl), 0xF, 0xF, true))
constexpr int ALD = 72;
__device__ __forceinline__ unsigned cvt_pk_nv(float lo, float hi) { unsigned r; asm("v_cvt_pk_bf16_f32 %0, %1, %2" : "=v"(r) : "v"(lo), "v"(hi)); return r; }
__device__ __forceinline__ void attn_phase(LAS unsigned char* lds, const bf16* Q, const bf16* K, const bf16* V, bf16* OB, const float* qg, const float* kg, const float* relb, int wid_s) {
    unsigned z_ = 0u; asm volatile("" : "+v"(z_)); const int tid = wid_s * 64 + (int)__builtin_amdgcn_mbcnt_hi(~0u, __builtin_amdgcn_mbcnt_lo(~0u, z_)); const int wid = __builtin_amdgcn_readfirstlane(tid >> 6), lane = tid & 63;
    const int fr = lane & 15, fq = lane >> 4;
    LAS bf16* Ks = (LAS bf16*)lds; LAS bf16* Vt = (LAS bf16*)(lds + 2 * 64 * ALD * 2); LAS float* biasS = (LAS float*)(lds + 4 * 64 * ALD * 2);
    const int skey = tid >> 3, spart = tid & 7;
    const int vwcol = skey ^ (spart << 3), vrcol = (fq * 4) ^ ((fr >> 3) << 3);
    float kgv[8];
#pragma unroll
    for (int i = 0; i < 8; ++i) kgv[i] = kg[spart * 8 + i];
    float qgv[2][8];
#pragma unroll
    for (int ks = 0; ks < 2; ++ks)
#pragma unroll
        for (int i = 0; i < 8; ++i) qgv[ks][i] = qg[ks * 32 + fq * 8 + i] * (0.125f * 1.44269504089f);
    v4u krA = (v4u){0u, 0u, 0u, 0u}, vrA = krA, krB = krA, vrB = krA, nq0 = krA, nq1 = krA; float nbias = 0.f; bool pre = false;
    for (int u = blockIdx.x; u < 4096; u += gridDim.x) {
        const int cp = u & 31, h = (u >> 5) & 7, b = u >> 8;
        const int un = u + gridDim.x; const bool has_next = un < 4096; const int cpn = un & 31, hn = (un >> 5) & 7, bn = un >> 8; const int jt0n = (8 - 2 * cpn) > 0 ? (8 - 2 * cpn) : 0;
        const size_t kvbase_n = ((size_t)bn * SEQ + (size_t)(2 * cpn - 8) * 64 + skey) * 512 + hn * 64 + spart * 8;
        const size_t qoff_n = ((size_t)bn * SEQ + (2 * cpn + (wid >> 2)) * 64 + (wid & 3) * 16 + fr) * 512 + hn * 64 + fq * 8;
        const int c = 2 * cp + (wid >> 2); const size_t qrow = (size_t)b * SEQ + c * 64 + (wid & 3) * 16 + fr;
        if (tid < 257) biasS[tid] = (pre ? nbias : relb[h * 257 + tid]) * 1.44269504089f;
        bf16x8 Qb[2];
        { v4u raw[2]; float f[2][8]; float ss = 0.f;
#pragma unroll
            for (int ks = 0; ks < 2; ++ks) { raw[ks] = pre ? (ks ? nq1 : nq0) : *(const v4u*)(Q + qrow * 512 + h * 64 + ks * 32 + fq * 8);
                f[ks][0] = bflo(raw[ks].x); f[ks][1] = bfhi(raw[ks].x); f[ks][2] = bflo(raw[ks].y); f[ks][3] = bfhi(raw[ks].y); f[ks][4] = bflo(raw[ks].z); f[ks][5] = bfhi(raw[ks].z); f[ks][6] = bflo(raw[ks].w); f[ks][7] = bfhi(raw[ks].w);
#pragma unroll
                for (int i = 0; i < 8; ++i) ss += f[ks][i] * f[ks][i]; }
            ss += shx(ss, 16, lane); ss += shx(ss, 32, lane);
            const float rq = 1.0f / sqrtf(ss * (1.f / 64.f) + EPS);
#pragma unroll
            for (int ks = 0; ks < 2; ++ks) { v4u w; w.x = pk2(f[ks][0] * rq * qgv[ks][0], f[ks][1] * rq * qgv[ks][1]); w.y = pk2(f[ks][2] * rq * qgv[ks][2], f[ks][3] * rq * qgv[ks][3]);
                w.z = pk2(f[ks][4] * rq * qgv[ks][4], f[ks][5] * rq * qgv[ks][5]); w.w = pk2(f[ks][6] * rq * qgv[ks][6], f[ks][7] * rq * qgv[ks][7]); Qb[ks] = __builtin_bit_cast(bf16x8, w); } }
        f32x4 o[4];
#pragma unroll
        for (int d = 0; d < 4; ++d) o[d] = (f32x4){0.f, 0.f, 0.f, 0.f};
        float lsum = 0.f;
        const int jt0 = (8 - 2 * cp) > 0 ? (8 - 2 * cp) : 0;
        const size_t kvbase = ((size_t)b * SEQ + (size_t)(2 * cp - 8) * 64 + skey) * 512 + h * 64 + spart * 8;
#define ATT_LOAD(KR, VR, JT) do { KR = *(const v4u*)(K + kvbase + (size_t)(JT) * 64 * 512); VR = *(const v4u*)(V + kvbase + (size_t)(JT) * 64 * 512); } while (0)
#define ATT_STAGE(KR, VR, BUF) do { \
            { float f[8] = {bflo(KR.x), bfhi(KR.x), bflo(KR.y), bfhi(KR.y), bflo(KR.z), bfhi(KR.z), bflo(KR.w), bfhi(KR.w)}; float ss = 0.f; \
                _Pragma("unroll") for (int i = 0; i < 8; ++i) ss += f[i] * f[i]; \
                ss += DPPF(ss, 0xB1); ss += DPPF(ss, 0x4E); ss += DPPF(ss, 0x141);     \
                const float rk = __builtin_amdgcn_rsqf(ss * (1.f / 64.f) + EPS); \
                v4u w; w.x = cvt_pk_nv(f[0] * rk * kgv[0], f[1] * rk * kgv[1]); w.y = cvt_pk_nv(f[2] * rk * kgv[2], f[3] * rk * kgv[3]); w.z = cvt_pk_nv(f[4] * rk * kgv[4], f[5] * rk * kgv[5]); w.w = cvt_pk_nv(f[6] * rk * kgv[6], f[7] * rk * kgv[7]); \
                *(LAS v4u*)(Ks + (BUF) * 64 * ALD + skey * ALD + spart * 8) = w; } \
            { LAS bf16* vp = Vt + (BUF) * 64 * ALD + (spart * 8) * ALD + vwcol; \
                vp[0 * ALD] = (bf16)(VR.x & 0xffffu); vp[1 * ALD] = (bf16)(VR.x >> 16); vp[2 * ALD] = (bf16)(VR.y & 0xffffu); vp[3 * ALD] = (bf16)(VR.y >> 16); \
                vp[4 * ALD] = (bf16)(VR.z & 0xffffu); vp[5 * ALD] = (bf16)(VR.z >> 16); vp[6 * ALD] = (bf16)(VR.w & 0xffffu); vp[7 * ALD] = (bf16)(VR.w >> 16); } } while (0)
#define ATT_BAR() do { asm volatile("s_waitcnt lgkmcnt(0)" ::: "memory"); __builtin_amdgcn_s_barrier(); asm volatile("" ::: "memory"); } while (0)
#define ATT_COMPUTE(JT, BUF) do { const int dt = c - (2 * cp - 8 + (JT)); \
            if (dt >= 0 && dt <= 8) { \
                f32x4 s[4]; \
                _Pragma("unroll") for (int blk = 0; blk < 4; ++blk) { s[blk] = (f32x4){0.f, 0.f, 0.f, 0.f}; \
                    _Pragma("unroll") for (int ks = 0; ks < 2; ++ks) { const bf16x8 a = *(const LAS bf16x8*)(Ks + (BUF) * 64 * ALD + (blk * 16 + fr) * ALD + ks * 32 + fq * 8); s[blk] = __builtin_amdgcn_mfma_f32_16x16x32_bf16(a, Qb[ks], s[blk], 0, 0, 0); } } \
                if (dt >= 3) { const float bc = biasS[256]; \
                    _Pragma("unroll") for (int blk = 0; blk < 4; ++blk) _Pragma("unroll") for (int j = 0; j < 4; ++j) s[blk][j] = __builtin_amdgcn_exp2f(s[blk][j] + bc); \
                } else { const int dbase = dt * 64 + (wid & 3) * 16 + fr - fq * 4; \
                    _Pragma("unroll") for (int blk = 0; blk < 4; ++blk) _Pragma("unroll") for (int j = 0; j < 4; ++j) { int d = dbase - blk * 16 - j; d = d > 128 ? 128 : d; s[blk][j] = __builtin_amdgcn_exp2f(s[blk][j] + biasS[d + 128]); } } \
                bf16x8 Pb[2]; \
                _Pragma("unroll") for (int ks = 0; ks < 2; ++ks) { const f32x4 p0 = s[2 * ks], p1 = s[2 * ks + 1]; lsum += (p0[0] + p0[1]) + (p0[2] + p0[3]) + (p1[0] + p1[1]) + (p1[2] + p1[3]); \
                    v4u w; w.x = cvt_pk_nv(p0[0], p0[1]); w.y = cvt_pk_nv(p0[2], p0[3]); w.z = cvt_pk_nv(p1[0], p1[1]); w.w = cvt_pk_nv(p1[2], p1[3]); Pb[ks] = __builtin_bit_cast(bf16x8, w); } \
                _Pragma("unroll") for (int db = 0; db < 4; ++db) _Pragma("unroll") for (int ks = 0; ks < 2; ++ks) { const LAS bf16* vr = Vt + (BUF) * 64 * ALD + (db * 16 + fr) * ALD + vrcol; \
                        const v2u lo = *(const LAS v2u*)(vr + (((2 * ks) ^ db) << 4)), hi = *(const LAS v2u*)(vr + (((2 * ks + 1) ^ db) << 4));     \
                        v4u w; w.x = lo.x; w.y = lo.y; w.z = hi.x; w.w = hi.y; \
                        o[db] = __builtin_amdgcn_mfma_f32_16x16x32_bf16(__builtin_bit_cast(bf16x8, w), Pb[ks], o[db], 0, 0, 0); } \
            } } while (0)
#define ATT_LOADN(KR, VR, JT) do { KR = *(const v4u*)(K + kvbase_n + (size_t)(JT) * 64 * 512); VR = *(const v4u*)(V + kvbase_n + (size_t)(JT) * 64 * 512); } while (0)
        if (!pre) { ATT_LOAD(krA, vrA, jt0); ATT_LOAD(krB, vrB, jt0 + 1); }
        ATT_STAGE(krA, vrA, 0);
        if (jt0 + 2 < 10) ATT_LOAD(krA, vrA, jt0 + 2); else if (has_next) ATT_LOADN(krA, vrA, jt0n);
        ATT_BAR();
        for (int jt = jt0; jt < 10; jt += 2) {
            ATT_STAGE(krB, vrB, 1);
            if (jt + 3 < 10) ATT_LOAD(krB, vrB, jt + 3);
            else if (has_next) { ATT_LOADN(krB, vrB, jt0n + 1); nq0 = *(const v4u*)(Q + qoff_n); nq1 = *(const v4u*)(Q + qoff_n + 32); if (tid < 257) nbias = relb[hn * 257 + tid]; }
            ATT_COMPUTE(jt, 0);
            ATT_BAR();
            if (jt + 2 < 10) { ATT_STAGE(krA, vrA, 0); if (jt + 4 < 10) ATT_LOAD(krA, vrA, jt + 4); else if (has_next) ATT_LOADN(krA, vrA, jt0n); }
            ATT_COMPUTE(jt + 1, 1);
            ATT_BAR();
        }
#undef ATT_LOAD
#undef ATT_LOADN
#undef ATT_STAGE
#undef ATT_BAR
#undef ATT_COMPUTE
        lsum += shx(lsum, 16, lane); lsum += shx(lsum, 32, lane);
        const float inv = 1.0f / lsum;
        bf16* op = OB + qrow * DM + 256 + h * 64 + fq * 4;
#pragma unroll
        for (int db = 0; db < 4; ++db) { v2u w; w.x = pk2(o[db][0] * inv, o[db][1] * inv); w.y = pk2(o[db][2] * inv, o[db][3] * inv); *(v2u*)(op + db * 16) = w; }
        pre = has_next;
        asm volatile("s_waitcnt lgkmcnt(0)" ::: "memory"); __builtin_amdgcn_s_barrier(); asm volatile("" ::: "memory");
    }
    __syncthreads();
}

__device__ __forceinline__ void conv_phase(LAS unsigned char* lds, const bf16* ZG, bf16* OB, const float* wdw, const float* bdw, const float* lng, const float* lnb, int wid_s) {
    unsigned z_ = 0u; asm volatile("" : "+v"(z_)); const int tid = wid_s * 64 + (int)__builtin_amdgcn_mbcnt_hi(~0u, __builtin_amdgcn_mbcnt_lo(~0u, z_)); const int wid = __builtin_amdgcn_readfirstlane(tid >> 6), lane = tid & 63;
    LAS float* wS = (LAS float*)lds; LAS float* xS = (LAS float*)(lds + 32768);
    for (int i = tid; i < 31 * 256; i += 512) wS[i] = wdw[i];
    const f32x4 bias4 = ((const f32x4*)bdw)[lane], g4 = ((const f32x4*)lng)[lane], b4 = ((const f32x4*)lnb)[lane];
    for (int tile = blockIdx.x; tile < 1024; tile += gridDim.x) {
        const int b = tile >> 6, tin = (tile & 63) * 64;
        v4u sv[6];
#pragma unroll
        for (int q = 0; q < 6; ++q) { const int i = tid + q * 512; const int r = i >> 5, pc = i & 31; const int pos = tin - 30 + r; sv[q] = (v4u){0u, 0u, 0u, 0u};
            if (i < 94 * 32 && pos >= 0) sv[q] = *(const v4u*)(ZG + ((size_t)b * SEQ + pos) * 256 + pc * 8); }
        asm volatile("s_waitcnt lgkmcnt(0)" ::: "memory"); __builtin_amdgcn_s_barrier(); asm volatile("" ::: "memory");
#pragma unroll
        for (int q = 0; q < 6; ++q) { const int i = tid + q * 512; const int r = i >> 5, pc = i & 31; const v4u v = sv[q];
            if (i < 94 * 32) { LAS f32x4* d = (LAS f32x4*)(xS + r * 256 + pc * 8); d[0] = (f32x4){bflo(v.x), bfhi(v.x), bflo(v.y), bfhi(v.y)}; d[1] = (f32x4){bflo(v.z), bfhi(v.z), bflo(v.w), bfhi(v.w)}; } }
        asm volatile("s_waitcnt lgkmcnt(0)" ::: "memory"); __builtin_amdgcn_s_barrier(); asm volatile("" ::: "memory");
        f32x4 acc[8];
#pragma unroll
        for (int j = 0; j < 8; ++j) acc[j] = bias4;
        const LAS float* xb = xS + (wid * 8) * 256 + lane * 4;
        for (int k = 0; k < 31; ++k) { const f32x4 w = *(const LAS f32x4*)(wS + k * 256 + lane * 4);
#pragma unroll
            for (int j = 0; j < 8; ++j) { const f32x4 x = *(const LAS f32x4*)(xb + (j + k) * 256); acc[j] += x * w; } }
#pragma unroll
        for (int j = 0; j < 8; ++j) { const int tok = wid * 8 + j; const f32x4 a4 = acc[j];
            const float mu = wave_sum((a4.x + a4.y) + (a4.z + a4.w), lane) * (1.f / 256.f); const f32x4 d = a4 - mu;
            const float var = wave_sum((d.x * d.x + d.y * d.y) + (d.z * d.z + d.w * d.w), lane) * (1.f / 256.f); const float rstd = 1.0f / sqrtf(var + EPS);
            f32x4 y = d * rstd * g4 + b4; y.x *= fsigmoid(y.x); y.y *= fsigmoid(y.y); y.z *= fsigmoid(y.z); y.w *= fsigmoid(y.w);
            v2u w; w.x = pk2(y.x, y.y); w.y = pk2(y.z, y.w); *(v2u*)(OB + ((size_t)b * SEQ + tin + tok) * DM + 768 + lane * 4) = w; }
    }
    __syncthreads();
}

#define WSP(T_, off) ((T_*)(ka->ws + (off)))
__global__ void __launch_bounds__(NWAVES * 64, 2) fwd_megakernel(Args args_unused) {
    extern __shared__ __attribute__((aligned(16))) unsigned char lds_raw[];
    cg::grid_group grid = cg::this_grid();
    LAS unsigned char* lds = (LAS unsigned char*)lds_raw;
#define GRID_SYNC() do { unsigned z__ = 0u; asm volatile("" : "+v"(z__)); const bool ld__ = (wid_s == 0) && (__builtin_amdgcn_mbcnt_hi(~0u, __builtin_amdgcn_mbcnt_lo(~0u, z__)) == 0u); \
        XcdBarrier xb__ = xbar; asm volatile("" : "+s"(xb__.bar)); xcd_barrier(xb__, ld__);     } while (0)
    const int wid_s = __builtin_amdgcn_readfirstlane((int)threadIdx.x >> 6);
    if (threadIdx.x < 16) ((LAS unsigned*)(lds + LDS_BYTES - 64))[threadIdx.x] = 0u;
    __syncthreads();
    grid.sync();
    XcdBarrier xbar = xcd_barrier_post((unsigned*)(kargs()->ws), (volatile LAS unsigned*)(lds + LDS_BYTES - 64), threadIdx.x == 0);

    {
        KArgs ka = kargs(); unsigned char* ws = ka->ws;
        unsigned z_ = 0u; asm volatile("" : "+v"(z_)); const int tid = wid_s * 64 + (int)__builtin_amdgcn_mbcnt_hi(~0u, __builtin_amdgcn_mbcnt_lo(~0u, z_)); const int wid = __builtin_amdgcn_readfirstlane(tid >> 6), lane = tid & 63;
        const int G = gridDim.x, cu = blockIdx.x; const int gtid = cu * 512 + tid;
        LAS float* scr = (LAS float*)(lds + wid * 16384);
        const int gw = cu * NWAVES + wid, NGW = G * NWAVES;
        constexpr int I_UP = 16 * 176, I_DN = 44 * 32, I_INA = 16 * 56, I_INB = 16 * 16, I_INC = 16 * 96, I_GLU = 4 * 16, I_BS = 4 * 32, I_BA = 8 * 32, I_BC = 4 * 32, I_OUT = 16 * 32;
        constexpr int PER_L = 2 * I_UP + 2 * I_DN + I_INA + I_INB + I_INC + I_GLU + I_BS + I_BA + I_BC + I_OUT;
        for (int it = gw; it < 2 * PER_L; it += NGW) {
            const int l = it >= PER_L ? 1 : 0; int r = it - l * PER_L;
            unsigned char* wl = ws + WS_W + (size_t)l * W_LSTRIDE;
            if (r < I_UP) { p0_transpose_item(ka->in[2] + (size_t)l * DM * NUP, NUP, 0, 2, FF, NUP, (bf16*)(wl + WO_UP1), 0, DM, 0, scr, r, lane, ka->in[1] + l * DM); continue; } r -= I_UP;
            if (r < I_DN) { p0_transpose_item(ka->in[3] + (size_t)l * FF * DM, DM, 0, 0, 0, DM, (bf16*)(wl + WO_DN1), 0, FF, 0, scr, r, lane); continue; } r -= I_DN;
            if (r < I_INA) { p0_transpose_item(ka->in[5] + (size_t)l * DM * INC, INC, 0, 0, 0, 1792, (bf16*)(wl + WO_IN), 0, DM, 0, scr, r, lane, ka->in[4] + l * DM); continue; } r -= I_INA;
            if (r < I_INB) { p0_transpose_item(ka->in[5] + (size_t)l * DM * INC, INC, 1792, 1, 256, 512, (bf16*)(wl + WO_IN), 1792, DM, 0, scr, r, lane, ka->in[4] + l * DM); continue; } r -= I_INB;
            if (r < I_INC) { p0_transpose_item(ka->in[5] + (size_t)l * DM * INC, INC, 2304, 0, 0, 3072, (bf16*)(wl + WO_IN), 2304, DM, 0, scr, r, lane, ka->in[4] + l * DM); continue; } r -= I_INC;
            if (r < I_GLU) { p0_transpose_item(ka->in[15] + (size_t)l * 256 * 512, 512, 0, 1, 256, 512, (bf16*)(wl + WO_GLU), 0, 256, 0, scr, r, lane); continue; } r -= I_GLU;
            if (r < I_BS) { p0_transpose_item(ka->in[16] + (size_t)l * 256 * DM, DM, 0, 0, 0, DM, (bf16*)(wl + WO_BR), 0, DM, 0, scr, r, lane); continue; } r -= I_BS;
            if (r < I_BA) { p0_transpose_item(ka->in[20] + (size_t)l * 512 * DM, DM, 0, 0, 0, DM, (bf16*)(wl + WO_BR), 0, DM, 256, scr, r, lane); continue; } r -= I_BA;
            if (r < I_BC) { p0_transpose_item(ka->in[25] + (size_t)l * 256 * DM, DM, 0, 0, 0, DM, (bf16*)(wl + WO_BR), 0, DM, 768, scr, r, lane); continue; } r -= I_BC;
            if (r < I_OUT) { p0_transpose_item(ka->in[26] + (size_t)l * DM * DM, DM, 0, 0, 0, DM, (bf16*)(wl + WO_OUT), 0, DM, 0, scr, r, lane); continue; } r -= I_OUT;
            if (r < I_UP) { p0_transpose_item(ka->in[28] + (size_t)l * DM * NUP, NUP, 0, 2, FF, NUP, (bf16*)(wl + WO_UP2), 0, DM, 0, scr, r, lane, ka->in[27] + l * DM); continue; } r -= I_UP;
            p0_transpose_item(ka->in[29] + (size_t)l * FF * DM, DM, 0, 0, 0, DM, (bf16*)(wl + WO_DN2), 0, FF, 0, scr, r, lane);
        }
        { rss_t* rz = (rss_t*)(ws + WS_RSS) + T; for (int i = gtid; i < 5 * T; i += G * 512) rz[i] = 0ull; }
        rawnorm_phase(ka->in[0], (bf16*)(ws + WS_XN), (rss_t*)(ws + WS_RSS), wid_s);
        if (gtid < 2048) {
            f32x2* APOW = (f32x2*)(ws + WS_APOW); f32x2* BBAR = (f32x2*)(ws + WS_BBAR);
            const int lg = gtid >> 6, p = gtid & 63;
            const float lre = fminf(ka->in[7][gtid], -1e-4f), lim = ka->in[8][gtid], dt = expf(ka->in[9][lg]);
            const float mag = expf(lre * dt), ang = lim * dt; double sd, cd; dsincos((double)ang, sd, cd);
            const float ar = mag * (float)cd, ai = mag * (float)sd;
            const float den = lre * lre + lim * lim; const float cr = ((ar - 1.0f) * lre + ai * lim) / den, ci = (ai * lre - (ar - 1.0f) * lim) / den;
            for (int c = 0; c < 16; ++c) { const float br = ka->in[10][(size_t)gtid * 16 + c], bi = ka->in[11][(size_t)gtid * 16 + c]; BBAR[(size_t)gtid * 16 + c] = (f32x2){cr * br - ci * bi, cr * bi + ci * br}; }
            double pr = 1.0, pi = 0.0; const double dar = (double)mag * cd, dai = (double)mag * sd;
            for (int lag = 0; lag <= 64; ++lag) { APOW[((size_t)lg * 65 + lag) * 64 + p] = (f32x2){(float)pr, (float)pi}; const double nr = pr * dar - pi * dai, ni = pr * dai + pi * dar; pr = nr; pi = ni; }
        }
    }
    GRID_SYNC();
#define RSS(j) ((float*)(ka->ws + WS_RSS) + (size_t)(j) * T)
#define WL(off) ((const bf16*)(ka->ws + WS_W + (size_t)l * W_LSTRIDE + (off)))
#pragma nounroll
    for (int l = 0; l < 2; ++l) {
        if (l == 0) {
    {
        KArgs ka = kargs(); unsigned char* ws = ka->ws; const f32x2* APOW = (const f32x2*)(ws + WS_APOW); const f32x2* BBAR = (const f32x2*)(ws + WS_BBAR); float* KMAT = (float*)(ws + WS_KMAT);
        unsigned z_ = 0u; asm volatile("" : "+v"(z_)); const int tid = wid_s * 64 + (int)__builtin_amdgcn_mbcnt_hi(~0u, __builtin_amdgcn_mbcnt_lo(~0u, z_)); const int gtid = blockIdx.x * 512 + tid, NT = gridDim.x * 512;
#pragma unroll 2
        for (int it = gtid; it < 2 * 16 * 64 * 256; it += NT) {
            const int ci = it & 15, co = (it >> 4) & 15, lag = (it >> 8) & 63, lg = it >> 14;
            const float* cre = ka->in[12] + ((size_t)lg * 16 + co) * 64; const float* cim = ka->in[13] + ((size_t)lg * 16 + co) * 64;
            const f32x2* ap = APOW + ((size_t)lg * 65 + lag) * 64; const f32x2* bb = BBAR + (size_t)lg * 64 * 16 + ci;
            float s = 0.f;
#pragma unroll 8
            for (int p = 0; p < 64; ++p) { const f32x2 a = ap[p], b = bb[p * 16]; const float wr_ = a.x * b.x - a.y * b.y, wi_ = a.x * b.y + a.y * b.x; s += cre[p] * wr_ - cim[p] * wi_; }
            if (lag == 0 && co == ci) s += ka->in[14][lg * 16 + co];
            KMAT[it] = s;
        }
    }
            }
        { KArgs ka = kargs(); const int G = gridDim.x, cu = blockIdx.x;
          pg8::Gemm g{WSP(bf16, WS_XN), WL(WO_UP1), T, NUP, DM, DM, DM}; pg8::StaticOrder S; S.init(T, NUP, G, cu); EpiSwiGlu E{WSP(bf16, WS_H), FF, l * 3 + 0};
          pg8::gemm_phase<EpiSwiGlu, pg8::StaticOrder, true, true>(lds, g, S, E, wid_s); }
        GRID_SYNC();
        if (l == 0) {
    {
        KArgs ka = kargs(); unsigned char* ws = ka->ws; const f32x2* APOW = (const f32x2*)(ws + WS_APOW); const f32x2* BBAR = (const f32x2*)(ws + WS_BBAR); const float* KMAT = (const float*)(ws + WS_KMAT);
        unsigned z_ = 0u; asm volatile("" : "+v"(z_)); const int tid = wid_s * 64 + (int)__builtin_amdgcn_mbcnt_hi(~0u, __builtin_amdgcn_mbcnt_lo(~0u, z_)); const int gtid = blockIdx.x * 512 + tid, NT = gridDim.x * 512;
#pragma unroll 2
        for (int it = gtid; it < 2 * 16 * BS5_ROWS * 144; it += NT) {
            const int k8 = it % 144; const int n = (it / 144) % BS5_ROWS; const int lg = it / (144 * BS5_ROWS); const int l = lg >> 4, g = lg & 15;
            float v[8];
#pragma unroll
            for (int q = 0; q < 8; ++q) v[q] = 0.f;
            if (n < 1024) { const int i = n >> 4, co = n & 15;
                if (k8 < 128) { const int j = k8 >> 1, ci0 = (k8 & 1) * 8;
                    if (j <= i) { const f32x4* kp = (const f32x4*)(KMAT + (((size_t)lg * 64 + (i - j)) * 16 + co) * 16 + ci0); const f32x4 a = kp[0], b = kp[1]; v[0] = a.x; v[1] = a.y; v[2] = a.z; v[3] = a.w; v[4] = b.x; v[5] = b.y; v[6] = b.z; v[7] = b.w; }
                } else { const int p0 = (k8 - 128) * 4;
#pragma unroll
                    for (int q = 0; q < 4; ++q) { const int p = p0 + q; const float cre = ka->in[12][((size_t)lg * 16 + co) * 64 + p], cim = ka->in[13][((size_t)lg * 16 + co) * 64 + p]; const f32x2 a = APOW[((size_t)lg * 65 + i + 1) * 64 + p];
                        v[2 * q] = cre * a.x - cim * a.y; v[2 * q + 1] = -(cre * a.y + cim * a.x); } }
            } else if (n < 1152) { const int s = n & 1, p = (n - 1024) >> 1;
                if (k8 < 128) { const int j = k8 >> 1, ci0 = (k8 & 1) * 8; const f32x2 a = APOW[((size_t)lg * 65 + 63 - j) * 64 + p];
#pragma unroll
                    for (int q = 0; q < 8; ++q) { const f32x2 b = BBAR[((size_t)lg * 64 + p) * 16 + ci0 + q]; v[q] = s ? (a.x * b.y + a.y * b.x) : (a.x * b.x - a.y * b.y); } }
            }
            v4u w; w.x = pk2(v[0], v[1]); w.y = pk2(v[2], v[3]); w.z = pk2(v[4], v[5]); w.w = pk2(v[6], v[7]);
            *(v4u*)((bf16*)(ws + WS_W + (size_t)l * W_LSTRIDE + WO_BS5) + ((size_t)(g * BS5_ROWS + n) * AS5_LD + k8 * 8)) = w;
        }
    }
            }
        { KArgs ka = kargs(); const int G = gridDim.x, cu = blockIdx.x;
          pg8::Gemm g{WSP(bf16, WS_H), WL(WO_DN1), T, DM, FF, FF, FF}; pg8::StaticOrder S; S.init(T, DM, G, cu); EpiResid E{0, 0.5f, l * 3 + 1};
          pg8::gemm_phase<EpiResid, pg8::StaticOrder, true, true>(lds, g, S, E, wid_s); }
        GRID_SYNC();
        { KArgs ka = kargs(); const int G = gridDim.x, cu = blockIdx.x;
          pg8::Gemm g{WSP(bf16, WS_XN), WL(WO_IN), T, INC, DM, DM, DM}; pg8::StaticOrder S; S.init(T, INC, G, cu);
          EpiIn E{WSP(bf16, WS_AS5), WSP(bf16, WS_Q), WSP(bf16, WS_ZG), (unsigned char*)(ka->ws + WS_G), l * 3 + 1, ka->in[6] + l * 3072};
          pg8::gemm_phase<EpiIn, pg8::StaticOrder, true, true>(lds, g, S, E, wid_s); }
        GRID_SYNC();
        { KArgs ka = kargs(); const int G = gridDim.x, cu = blockIdx.x;
          pg8::Gemm g{WSP(bf16, WS_AS5), WL(WO_BS5), 16 * 1024, 16 * BS5_ROWS, 1024, AS5_LD, AS5_LD}; S5Order1 S{G, cu}; EpiS5State E{WSP(bf16, WS_AS5), WSP(const f32x2, WS_APOW) + (size_t)l * 16 * 65 * 64};
          pg8::gemm_phase<EpiS5State, S5Order1, false, true>(lds, g, S, E, wid_s); }
        __syncthreads();
        { KArgs ka = kargs(); attn_phase(lds, WSP(bf16, WS_Q), WSP(bf16, WS_K), WSP(bf16, WS_V), (bf16*)ka->out, ka->in[17] + l * 64, ka->in[18] + l * 64, ka->in[19] + l * 8 * 257, wid_s); }
        { KArgs ka = kargs(); conv_phase(lds, WSP(bf16, WS_ZG), (bf16*)ka->out, ka->in[21] + l * 31 * 256, ka->in[22] + l * 256, ka->in[23] + l * 256, ka->in[24] + l * 256, wid_s); }
        GRID_SYNC();
        { KArgs ka = kargs(); const int G = gridDim.x, cu = blockIdx.x;
          pg8::Gemm g{WSP(bf16, WS_AS5), WL(WO_BS5), 16 * 1024, 16 * BS5_ROWS, AS5_LD, AS5_LD, AS5_LD}; S5Order2 S{G, cu}; EpiS5Y E{WSP(bf16, WS_ZG)};
          pg8::gemm_phase<EpiS5Y, S5Order2, true, true>(lds, g, S, E, wid_s); }
        GRID_SYNC();
        { KArgs ka = kargs(); const int G = gridDim.x, cu = blockIdx.x;
          pg8::Gemm g{WSP(bf16, WS_ZG), WL(WO_GLU), T, 512, 256, 256, 256}; pg8::StaticOrder S; S.init(T, 512, G, cu); EpiGlu<1> E{(bf16*)ka->out, DM, 0, -1};
          pg8::gemm_phase<EpiGlu<1>, pg8::StaticOrder, true, true>(lds, g, S, E, wid_s); }
        GRID_SYNC();
        { KArgs ka = kargs(); const int G = gridDim.x, cu = blockIdx.x;
          pg8::Gemm g{(const bf16*)ka->out, WL(WO_BR), T, DM, DM, DM, DM}; BranchOrder S; S.base.init(T, DM, G, cu); EpiBranchSeg E{(const unsigned char*)(ka->ws + WS_G), WSP(bf16, WS_MG)};
          pg8::gemm_phase<EpiBranchSeg, BranchOrder, true, true>(lds, g, S, E, wid_s); }
        GRID_SYNC();
        { KArgs ka = kargs(); const int G = gridDim.x, cu = blockIdx.x;
          pg8::Gemm g{WSP(bf16, WS_MG), WL(WO_OUT), T, DM, DM, DM, DM}; pg8::StaticOrder S; S.init(T, DM, G, cu); EpiResid E{0, 1.0f, l * 3 + 2};
          pg8::gemm_phase<EpiResid, pg8::StaticOrder, true, true>(lds, g, S, E, wid_s); }
        GRID_SYNC();
        { KArgs ka = kargs(); const int G = gridDim.x, cu = blockIdx.x;
          pg8::Gemm g{WSP(bf16, WS_XN), WL(WO_UP2), T, NUP, DM, DM, DM}; pg8::StaticOrder S; S.init(T, NUP, G, cu); EpiSwiGlu E{WSP(bf16, WS_H), FF, l * 3 + 2};
          pg8::gemm_phase<EpiSwiGlu, pg8::StaticOrder, true, true>(lds, g, S, E, wid_s); }
        GRID_SYNC();
        { KArgs ka = kargs(); const int G = gridDim.x, cu = blockIdx.x;
          pg8::Gemm g{WSP(bf16, WS_H), WL(WO_DN2), T, DM, FF, FF, FF}; pg8::StaticOrder S; S.init(T, DM, G, cu); EpiResid E{l == 1 ? 1 : 0, 0.5f, l == 0 ? 3 : -1};
          pg8::gemm_phase<EpiResid, pg8::StaticOrder, true, true>(lds, g, S, E, wid_s); }
        if (l == 0) GRID_SYNC();
    }
}

extern "C" void kernel_launch(void* const* d_in, const int* in_sizes, int n_in, void* d_out, int out_size, void* d_ws, size_t ws_size, hipStream_t stream) {
    static int grid = 0;
    if (grid == 0) {
        if (n_in != 30 || out_size != T * DM || ws_size < WS_END) { fprintf(stderr, "kernel_launch: unexpected shapes (n_in %d, out %d, ws %zu)\n", n_in, out_size, ws_size); grid = -1; return; }
        int dev = 0, cus = 0, per_cu = 0;
        hipGetDevice(&dev); hipDeviceGetAttribute(&cus, hipDeviceAttributeMultiprocessorCount, dev);
        hipFuncSetAttribute((const void*)fwd_megakernel, hipFuncAttributeMaxDynamicSharedMemorySize, LDS_BYTES);
        hipOccupancyMaxActiveBlocksPerMultiprocessor(&per_cu, (const void*)fwd_megakernel, NWAVES * 64, LDS_BYTES);
        if (per_cu < 1) { fprintf(stderr, "kernel_launch: occupancy query says %d blocks per CU\n", per_cu); per_cu = 1; }
        (void)hipGetLastError();
        grid = cus * 1;
    }
    if (grid < 0) return;
    (void)hipMemsetAsync(d_ws, 0, 65536, stream);
    Args a{};
    for (int i = 0; i < 30; ++i) a.in[i] = (const float*)d_in[i];
    a.out = (float*)d_out; a.ws = (unsigned char*)d_ws;
    void* kargs[] = {&a};
    hipError_t e = hipLaunchCooperativeKernel((const void*)fwd_megakernel, dim3(grid), dim3(NWAVES * 64), kargs, LDS_BYTES, stream);
    if (e != hipSuccess) fprintf(stderr, "cooperative launch failed: %s (grid %d)\n", hipGetErrorString(e), grid);
}
```

```cpp
#include <hip/hip_runtime.h>
#include <hip/hip_cooperative_groups.h>
#include <cstdio>
#include <cstdint>
namespace cg = cooperative_groups;
namespace pg8 {
#define PG8_LAS __attribute__((address_space(3)))
typedef unsigned short bf16_t;
typedef short bf16x8 __attribute__((ext_vector_type(8)));
typedef float f32x4 __attribute__((ext_vector_type(4)));
typedef unsigned u32x4 __attribute__((ext_vector_type(4)));
constexpr int BM = 256, BK = 64, HALF = 128, HTB = HALF * BK * 2  , STAGE_BYTES = 8 * HTB, NXCD = 8, WGM = 8;

__host__ __device__ __forceinline__ int lds_byte(int r, int c) { const int st = (r >> 4) * 2 + (c >> 5), rr = r & 15, cc = c & 31, ob = rr * 64 + cc * 2; return st * 1024 + (ob ^ (((ob >> 9) & 1) << 5)); }
__host__ __device__ __forceinline__ void stage_rc(int b, int& R, int& C) { const int st = b / 1024, sb = b % 1024, swz = sb ^ (((sb >> 9) & 1) << 5); R = (st >> 1) * 16 + swz / 64; C = (st & 1) * 32 + (swz % 64) / 2; }
__host__ __device__ __forceinline__ int perm32(int rho) { const int n = rho >> 4, i = rho & 15; return 8 * (i >> 2) + 4 * n + (i & 3); }

struct Unit { int pm, pn; int koff = 0, nt = 0, seg = 0; };
struct Gemm { const bf16_t* A; const bf16_t* Bt; int M, N, K, lda, ldb; };

struct StaticOrder {
    int nM, nN, nwg, G, c;
    __host__ __device__ void init(int M, int N, int G_, int c_) { nM = M / BM; nN = N / BM; nwg = nM * nN; G = G_; c = c_; }
    __host__ __device__ bool next(int i, Unit& u) const {
        const long L = (long)i * G + c; if (L >= nwg) return false;
        int wgid = (int)L; { const int q = nwg / NXCD, r = nwg % NXCD, xcd = wgid % NXCD, off = wgid / NXCD; wgid = (xcd < r ? xcd * (q + 1) : r * (q + 1) + (xcd - r) * q) + off; }
        const int nig = WGM * nN, gid = wgid / nig, fm = gid * WGM, gsz = (nM - fm) < WGM ? (nM - fm) : WGM;
        u.pm = fm + ((wgid % nig) % gsz); u.pn = (wgid % nig) / gsz; return true;
    }
    __device__ __forceinline__ void a_ready(const Unit&) const {}
    __device__ __forceinline__ void done(const Unit&) const {}
};

__device__ __forceinline__ unsigned cvt_pk_bf16(float lo, float hi) { unsigned r; asm volatile("v_cvt_pk_bf16_f32 %0, %1, %2" : "=v"(r) : "v"(lo), "v"(hi)); return r; }
typedef float f32x2 __attribute__((ext_vector_type(2)));
__device__ __forceinline__ f32x2 gelu_pk(f32x2 v) {
    const f32x2 av = __builtin_elementwise_abs(v), d = av * 0.2316418882f + 1.0f;
    f32x2 t; t.x = __builtin_amdgcn_rcpf(d.x); t.y = __builtin_amdgcn_rcpf(d.y);
    f32x2 q = t * 0.5307027145f + (-0.7265760135f); q = q * t + 0.7107068705f; q = q * t + (-0.142248368f); q = q * t + 0.127414796f; q = q * t;
    const f32x2 s = (v * v) * (-0.72134752044f);
    f32x2 e; e.x = __builtin_amdgcn_exp2f(s.x); e.y = __builtin_amdgcn_exp2f(s.y);
    const f32x2 m = v * (q * e), r = v - m;
    f32x2 o; o.x = v.x < 0.f ? m.x : r.x; o.y = v.y < 0.f ? m.y : r.y; return o;
}

template <int ACT  > struct EpiBf16 {
    static constexpr bool PERM = true, AFTER_DRAIN = false; static_assert(ACT == 0 || ACT == 1, "EpiBf16: ACT is 0 (none) or 1 (gelu_pk)");
    bf16_t* O; int ldc; const float* bias; int split_cols; size_t split_stride; float scale0;
    __device__ __forceinline__ void operator()(const f32x4 (&acc)[2][2][4][2], const Unit& u, int wr, int wc, int fr, int fq) const {
        const int row0 = u.pm * BM + wr * 64 + fr; int colt = u.pn * BM; bf16_t* base = O;
        float sc = 1.f; if (split_cols) { const int t = colt / split_cols; base += (size_t)t * split_stride; colt -= t * split_cols; if (t == 0) sc = scale0; }
        const int col0 = colt + wc * 32 + 8 * fq, bcol0 = u.pn * BM + wc * 32 + 8 * fq;
        f32x4 bv[2][2];
#pragma unroll
        for (int bj = 0; bj < 2; ++bj)
#pragma unroll
            for (int n = 0; n < 2; ++n) bv[bj][n] = bias ? *(const f32x4*)(bias + bcol0 + bj * HALF + 4 * n) : (f32x4){0.f, 0.f, 0.f, 0.f};
#pragma unroll
        for (int ai = 0; ai < 2; ++ai)
#pragma unroll
            for (int m = 0; m < 4; ++m) { bf16_t* rowp = base + (size_t)(row0 + ai * HALF + m * 16) * ldc + col0;
#pragma unroll
                for (int bj = 0; bj < 2; ++bj) { f32x4 v0 = acc[ai][bj][m][0] + bv[bj][0], v1 = acc[ai][bj][m][1] + bv[bj][1];
                    if (ACT == 1) { f32x2 a = gelu_pk((f32x2){v0[0], v0[1]}), b = gelu_pk((f32x2){v0[2], v0[3]}), c = gelu_pk((f32x2){v1[0], v1[1]}), d = gelu_pk((f32x2){v1[2], v1[3]});
                        v0 = (f32x4){a.x, a.y, b.x, b.y}; v1 = (f32x4){c.x, c.y, d.x, d.y}; }
                    v0 = v0 * sc; v1 = v1 * sc; u32x4 w; w.x = cvt_pk_bf16(v0[0], v0[1]); w.y = cvt_pk_bf16(v0[2], v0[3]); w.z = cvt_pk_bf16(v1[0], v1[1]); w.w = cvt_pk_bf16(v1[2], v1[3]);
                    *(u32x4*)(rowp + bj * HALF) = w; } }
    }
};

template <class Epi, class Sched, bool ALIGN_EPI = false, bool SP2 = false>
__device__ __forceinline__ void gemm_phase(PG8_LAS unsigned char* lds, const Gemm g, const Sched& S, const Epi& E, int wid_s) {
    unsigned z_ = 0u; asm volatile("" : "+v"(z_)); const int tid = wid_s * 64 + (int)__builtin_amdgcn_mbcnt_hi(~0u, __builtin_amdgcn_mbcnt_lo(~0u, z_));
    const int wid = __builtin_amdgcn_readfirstlane(tid >> 6), lane = tid & 63, wr = wid >> 2, wc = wid & 3, fr = lane & 15, fq = lane >> 4;
    int K = g.K; asm volatile("" : "+s"(K));
    const int nt = K / BK;
    unsigned voffA[2], voffB[2];
#pragma unroll
    for (int i = 0; i < 2; ++i) { int R, C; stage_rc(tid * 16 + i * 8192, R, C); const int Rb = Epi::PERM ? ((R & ~31) + perm32(R & 31)) : R;
        voffA[i] = (unsigned)(R * g.lda + C) * 2u; voffB[i] = (unsigned)(Rb * g.ldb + C) * 2u; }
    const size_t kstep = (size_t)(BK * 2);
    const size_t hstepA = (size_t)HALF * g.lda * 2, hstepB = (size_t)HALF * g.ldb * 2;
    const size_t tstepA = 2 * hstepA, tstepB = 2 * hstepB;
    const unsigned ldsw = (unsigned)wid * 1024u;
    const int aoff = lds_byte(wr * 64 + fr, fq * 8), boff = lds_byte(wc * 32 + fr, fq * 8);
#define PG8_SA(b, h) (((b) * 2 + (h)) * HTB)
#define PG8_SB(b, h) ((4 + (b) * 2 + (h)) * HTB)
#define PG8_STAGE(bufoff, gbase, voff) do { _Pragma("unroll") for (int _i = 0; _i < 2; ++_i) \
        __builtin_amdgcn_global_load_lds((const unsigned*)((const char*)(gbase) + (voff)[_i]), (PG8_LAS unsigned*)(lds + (bufoff) + ldsw + _i * 8192), 16, 0, 0); } while (0)
#define PG8_LDA(dst, b, h) do { _Pragma("unroll") for (int m = 0; m < 4; ++m) _Pragma("unroll") for (int k = 0; k < 2; ++k) dst[m][k] = *(const PG8_LAS bf16x8*)(lds + PG8_SA(b, h) + aoff + m * 2048 + k * 1024); } while (0)
#define PG8_LDB(dst, b, h) do { _Pragma("unroll") for (int n = 0; n < 2; ++n) _Pragma("unroll") for (int k = 0; k < 2; ++k) dst[n][k] = *(const PG8_LAS bf16x8*)(lds + PG8_SB(b, h) + boff + n * 2048 + k * 1024); } while (0)
#define PG8_MMA(ai, bj, At, Bt) do { __builtin_amdgcn_s_setprio(1); _Pragma("unroll") for (int m = 0; m < 4; ++m) _Pragma("unroll") for (int n = 0; n < 2; ++n) _Pragma("unroll") for (int k = 0; k < 2; ++k) \
        acc[ai][bj][m][n] = __builtin_amdgcn_mfma_f32_16x16x32_bf16(Bt[n][k], At[m][k], acc[ai][bj][m][n], 0, 0, 0); __builtin_amdgcn_s_setprio(0); } while (0)
#define PG8_WAIT_V(n) asm volatile("s_waitcnt vmcnt(" #n ")" ::: "memory")
#define PG8_WAIT_L(n) asm volatile("s_waitcnt lgkmcnt(" #n ")" ::: "memory")
#define PG8_BAR __builtin_amdgcn_s_barrier()
#define PG8_SCHED __builtin_amdgcn_sched_barrier(0)
    Unit cur, nxt; int ui = 0;
    if (!S.next(0, cur)) return;
    f32x4 acc[2][2][4][2];
#pragma unroll
    for (int a = 0; a < 2; ++a)
#pragma unroll
        for (int b = 0; b < 2; ++b)
#pragma unroll
            for (int m = 0; m < 4; ++m)
#pragma unroll
                for (int n = 0; n < 2; ++n) acc[a][b][m][n] = (f32x4){0.f, 0.f, 0.f, 0.f};
    bf16x8 At[4][2], B0[2][2], B1[2][2];
    const char* cA = (const char*)g.A + (size_t)cur.pm * tstepA + (size_t)cur.koff * 2; const char* cB = (const char*)g.Bt + (size_t)cur.pn * tstepB + (size_t)cur.koff * 2;
    S.a_ready(cur);
    if constexpr (SP2) {
        PG8_STAGE(PG8_SB(0, 0), cB, voffB); PG8_STAGE(PG8_SB(0, 1), cB + hstepB, voffB); PG8_STAGE(PG8_SA(0, 0), cA, voffA); PG8_STAGE(PG8_SA(0, 1), cA + hstepA, voffA);
        if (wr == 1) PG8_BAR;
        PG8_WAIT_V(2); PG8_BAR;
        PG8_STAGE(PG8_SB(1, 0), cB + kstep, voffB); PG8_STAGE(PG8_SA(1, 0), cA + kstep, voffA); PG8_STAGE(PG8_SB(1, 1), cB + hstepB + kstep, voffB);
        PG8_WAIT_V(6); PG8_BAR;
    } else {
        PG8_STAGE(PG8_SB(0, 0), cB, voffB); PG8_STAGE(PG8_SA(0, 0), cA, voffA); PG8_STAGE(PG8_SB(0, 1), cB + hstepB, voffB); PG8_STAGE(PG8_SA(0, 1), cA + hstepA, voffA);
        if (wr == 1) PG8_BAR;
        PG8_WAIT_V(4); PG8_BAR;
        PG8_STAGE(PG8_SB(1, 0), cB + kstep, voffB); PG8_STAGE(PG8_SA(1, 0), cA + kstep, voffA); PG8_STAGE(PG8_SB(1, 1), cB + hstepB + kstep, voffB);
        PG8_WAIT_V(6); PG8_BAR;
    }
    for (;;) {
        const bool has_next = S.next(ui + 1, nxt);
        const char* nA = has_next ? (const char*)g.A + (size_t)nxt.pm * tstepA + (size_t)nxt.koff * 2 : cA; const char* nB = has_next ? (const char*)g.Bt + (size_t)nxt.pn * tstepB + (size_t)nxt.koff * 2 : cB;
        const int ntc = cur.nt ? cur.nt : nt;
        for (int t = 0; t < ntc; t += 2) {
            const bool last = (t == ntc - 2);
            const char* a1 = cA + (size_t)(t + 1) * kstep;
            const char* a2 = last ? nA : cA + (size_t)(t + 2) * kstep; const char* b2 = last ? nB : cB + (size_t)(t + 2) * kstep;
            const char* a3 = a2 + kstep; const char* b3 = b2 + kstep;
            if (last && has_next) S.a_ready(nxt);
            if constexpr (SP2) {
            PG8_LDB(B0, 0, 0); PG8_LDB(B1, 0, 1); PG8_SCHED; PG8_LDA(At, 0, 0); PG8_STAGE(PG8_SA(1, 1), a1 + hstepA, voffA);
            PG8_WAIT_V(8); PG8_WAIT_L(0); PG8_BAR; PG8_MMA(0, 0, At, B0); PG8_MMA(0, 1, At, B1); PG8_BAR; PG8_SCHED;
            PG8_LDA(At, 0, 1); PG8_STAGE(PG8_SB(0, 0), b2, voffB); PG8_STAGE(PG8_SB(0, 1), b2 + hstepB, voffB); PG8_STAGE(PG8_SA(0, 0), a2, voffA);
            PG8_WAIT_V(8); PG8_WAIT_L(0); PG8_BAR; PG8_MMA(1, 0, At, B0); PG8_MMA(1, 1, At, B1); PG8_BAR; PG8_SCHED;
            PG8_LDB(B0, 1, 0); PG8_LDB(B1, 1, 1); PG8_SCHED; PG8_LDA(At, 1, 0); PG8_STAGE(PG8_SA(0, 1), a2 + hstepA, voffA);
            PG8_WAIT_V(8); PG8_WAIT_L(0); PG8_BAR; PG8_MMA(0, 0, At, B0); PG8_MMA(0, 1, At, B1); PG8_BAR; PG8_SCHED;
            PG8_LDA(At, 1, 1); PG8_STAGE(PG8_SB(1, 0), b3, voffB); PG8_STAGE(PG8_SB(1, 1), b3 + hstepB, voffB); PG8_STAGE(PG8_SA(1, 0), a3, voffA);
            PG8_WAIT_V(8); PG8_WAIT_L(0); PG8_BAR; PG8_MMA(1, 0, At, B0); PG8_MMA(1, 1, At, B1); PG8_BAR; PG8_SCHED;
            } else {
            PG8_LDB(B0, 0, 0); PG8_SCHED; PG8_LDA(At, 0, 0); PG8_STAGE(PG8_SA(1, 1), a1 + hstepA, voffA);
            PG8_WAIT_L(8); PG8_BAR; PG8_WAIT_L(0); PG8_MMA(0, 0, At, B0); PG8_BAR; PG8_SCHED;
            PG8_LDB(B1, 0, 1); PG8_STAGE(PG8_SB(0, 0), b2, voffB);
            PG8_BAR; PG8_WAIT_L(0); PG8_MMA(0, 1, At, B1); PG8_BAR;
            PG8_LDA(At, 0, 1); PG8_STAGE(PG8_SA(0, 0), a2, voffA);
            PG8_BAR; PG8_WAIT_L(0); PG8_MMA(1, 0, At, B0); PG8_BAR; PG8_SCHED;
            PG8_STAGE(PG8_SB(0, 1), b2 + hstepB, voffB);
            PG8_WAIT_V(6); PG8_BAR; PG8_MMA(1, 1, At, B1); PG8_BAR;
            PG8_LDB(B0, 1, 0); PG8_SCHED; PG8_LDA(At, 1, 0); PG8_STAGE(PG8_SA(0, 1), a2 + hstepA, voffA);
            PG8_WAIT_L(8); PG8_BAR; PG8_WAIT_L(0); PG8_MMA(0, 0, At, B0); PG8_BAR; PG8_SCHED;
            PG8_LDB(B1, 1, 1); PG8_STAGE(PG8_SB(1, 0), b3, voffB);
            PG8_BAR; PG8_WAIT_L(0); PG8_MMA(0, 1, At, B1); PG8_BAR;
            PG8_LDA(At, 1, 1); PG8_STAGE(PG8_SA(1, 0), a3, voffA);
            PG8_BAR; PG8_WAIT_L(0); PG8_MMA(1, 0, At, B0); PG8_BAR; PG8_SCHED;
            PG8_STAGE(PG8_SB(1, 1), b3 + hstepB, voffB);
            PG8_WAIT_V(6); PG8_BAR; PG8_MMA(1, 1, At, B1); PG8_BAR;
            }
        }
        if constexpr (ALIGN_EPI) { if (wr == 0) PG8_BAR; }
        if constexpr (!Epi::AFTER_DRAIN) { E(acc, cur, wr, wc, fr, fq); S.done(cur); }
        if (!has_next) break;
#pragma unroll
        for (int a = 0; a < 2; ++a)
#pragma unroll
            for (int b = 0; b < 2; ++b)
#pragma unroll
                for (int m = 0; m < 4; ++m)
#pragma unroll
                    for (int n = 0; n < 2; ++n) acc[a][b][m][n] = (f32x4){0.f, 0.f, 0.f, 0.f};
        cur = nxt; cA = nA; cB = nB; ++ui;
        if constexpr (ALIGN_EPI) { if (wr == 1) PG8_BAR; }
    }
    PG8_WAIT_V(0);
    if constexpr (!ALIGN_EPI) { if (wr == 0) PG8_BAR; }
    PG8_BAR;
    if constexpr (Epi::AFTER_DRAIN) { E.fused(acc, cur, wr, wc, fr, fq, lds, wid, lane); S.done(cur); }
#undef PG8_SA
#undef PG8_SB
#undef PG8_STAGE
#undef PG8_LDA
#undef PG8_LDB
#undef PG8_MMA
#undef PG8_WAIT_V
#undef PG8_WAIT_L
#undef PG8_BAR
#undef PG8_SCHED
}
}
constexpr int NWAVES = 8;
constexpr int T = 65536, DM = 1024, FF = 2816, NUP = 2 * FF, INC = 5376, SEQ = 4096, NB = 16;
constexpr float EPS = 1e-6f;
constexpr size_t MiB = 1u << 20;
constexpr size_t WS_APOW = 1 * MiB;
constexpr size_t WS_BBAR = 2 * MiB + 512 * 1024;
constexpr size_t WS_KMAT = 3 * MiB;
constexpr size_t WS_W = 5 * MiB, W_LSTRIDE = 93 * MiB;
constexpr size_t WO_UP1 = 0, WO_DN1 = 11 * MiB, WO_IN = 16 * MiB + 512 * 1024, WO_GLU = 27 * MiB, WO_BR = 27 * MiB + 256 * 1024, WO_OUT = 29 * MiB + 256 * 1024,
                 WO_UP2 = 31 * MiB + 256 * 1024, WO_DN2 = 42 * MiB + 256 * 1024, WO_BS5 = 47 * MiB + 768 * 1024;
constexpr size_t WS_XN = 192 * MiB;
constexpr size_t WS_H = 320 * MiB;
constexpr size_t WS_G = 320 * MiB;
constexpr size_t WS_Q = 704 * MiB, WS_K = 768 * MiB, WS_V = 832 * MiB;
constexpr size_t WS_MG = 704 * MiB;
constexpr size_t WS_AS5 = 896 * MiB;
constexpr size_t WS_ZG = 932 * MiB;
constexpr size_t WS_END = 968 * MiB;
typedef unsigned long long rss_t;
constexpr float RSS_FIX = 16777216.0f, RSS_INV = 1.0f / 16777216.0f;
constexpr size_t WS_RSS = 964 * MiB;
constexpr int LDS_BYTES = 147456;
constexpr int AS5_LD = 1152, BS5_ROWS = 1280;

#define GAS __attribute__((address_space(1)))
#define LAS __attribute__((address_space(3)))
typedef unsigned short bf16;
typedef unsigned v4u __attribute__((ext_vector_type(4)));
typedef unsigned v2u __attribute__((ext_vector_type(2)));
typedef float f32x4 __attribute__((ext_vector_type(4)));
typedef float f32x2 __attribute__((ext_vector_type(2)));
typedef short bf16x8 __attribute__((ext_vector_type(8)));
typedef short s16x4 __attribute__((ext_vector_type(4)));
__device__ __forceinline__ unsigned f2bf(float f) { unsigned u = __builtin_bit_cast(unsigned, f); return (u + 0x7fffu + ((u >> 16) & 1u)) >> 16; }
__device__ __forceinline__ unsigned pk2(float lo, float hi) { return f2bf(lo) | (f2bf(hi) << 16); }
__device__ __forceinline__ float bflo(unsigned w) { return __builtin_bit_cast(float, w << 16); }
__device__ __forceinline__ float bfhi(unsigned w) { return __builtin_bit_cast(float, w & 0xffff0000u); }
__device__ __forceinline__ float fsigmoid(float x) { return __builtin_amdgcn_rcpf(1.0f + __expf(-x)); }
__device__ __forceinline__ float shx(float v, int m, int lane) { return __builtin_bit_cast(float, __builtin_amdgcn_ds_bpermute((lane ^ m) << 2, __builtin_bit_cast(int, v))); }
__device__ __forceinline__ float wave_sum(float v, int lane) {
#pragma unroll
    for (int o = 1; o < 64; o <<= 1) v += shx(v, o, lane);
    return v;
}


#define XB_TMO      128
#define XB_XCNT(j)  (256  + 64 * (j))
#define XB_XSUB(j)  (1280 + 64 * (j))
#define XB_XGEN(j)  (2304 + 64 * (j))
#define XB_TOP      3328
#define XB_TOPGEN   3392
#define XCD_BAR_WORDS 3456
#define XB_SPIN_CAP (1u << 18)

__device__ __forceinline__ unsigned xb_ld(unsigned* p)              { return __hip_atomic_load(p, __ATOMIC_RELAXED, __HIP_MEMORY_SCOPE_AGENT); }
__device__ __forceinline__ unsigned xb_add(unsigned* p, unsigned v) { return __hip_atomic_fetch_add(p, v, __ATOMIC_RELAXED, __HIP_MEMORY_SCOPE_AGENT); }
__device__ __forceinline__ unsigned xb_xcc_id() { return (unsigned)__builtin_amdgcn_s_getreg((3 << 11) | 20) & 0xFu; }
#define XB_SPIN(cond, bar) do { unsigned _sp = 0; while (cond) { __builtin_amdgcn_s_sleep(1); \
    if ((++_sp & 255u) == 0u) { if (xb_ld(&(bar)[XB_TMO])) break; if (_sp > XB_SPIN_CAP) { atomicAdd(&(bar)[XB_TMO], 1u); break; } } } } while (0)

struct XcdBarrier {
    unsigned* bar; unsigned x;
    volatile LAS unsigned* st;
};

__device__ __forceinline__ XcdBarrier xcd_barrier_post(unsigned* bar, volatile LAS unsigned* st, bool leader) {
    XcdBarrier b; b.bar = bar; b.x = xb_xcc_id(); b.st = st;
    if (leader) (void)xb_add(&bar[XB_XCNT(b.x)], 1u);
    return b;
}
__device__ __forceinline__ void xcd_barrier_complete(unsigned* bar, unsigned x, unsigned& nloc, unsigned& nx) {
    const unsigned G = gridDim.x * gridDim.y * gridDim.z;
    unsigned sum, cnt, mine, sp = 0u;
    for (;;) {
        sum = 0u; cnt = 0u; mine = 0u;
#pragma unroll
        for (unsigned j = 0; j < 16; ++j) { const unsigned c = xb_ld(&bar[XB_XCNT(j)]); sum += c; cnt += (c > 0u) ? 1u : 0u; mine = (j == x) ? c : mine; }
        if (sum == G) break;
        __builtin_amdgcn_s_sleep(1);
        if ((++sp & 255u) == 0u) { if (xb_ld(&bar[XB_TMO])) break; if (sp > XB_SPIN_CAP) { atomicAdd(&bar[XB_TMO], 1u); break; } }
    }
    nloc = mine > 0u ? mine : 1u; nx = cnt > 0u ? cnt : 1u;
}

__device__ __forceinline__ void xcd_barrier(const XcdBarrier& b, bool leader) {
    asm volatile("s_waitcnt vmcnt(0)" ::: "memory");
    __syncthreads();
    if (leader) {
        unsigned* bar = b.bar;
        __builtin_amdgcn_s_waitcnt(0);
        unsigned nloc = b.st[0], nx = b.st[1];
        if (nloc == 0u) { xcd_barrier_complete(bar, b.x, nloc, nx); b.st[0] = nloc; b.st[1] = nx; }
        const unsigned old = xb_add(&bar[XB_XSUB(b.x)], 1u);
        const unsigned gen = old / nloc;
        if (old + 1u == (gen + 1u) * nloc) {
            __builtin_amdgcn_fence(__ATOMIC_RELEASE, "agent");
            asm volatile("s_waitcnt vmcnt(0)" ::: "memory");
            const unsigned og = xb_add(&bar[XB_TOP], 1u);
            const unsigned tg = og / nx;
            if (og + 1u == (tg + 1u) * nx) xb_add(&bar[XB_TOPGEN], 1u);
            else XB_SPIN(xb_ld(&bar[XB_TOPGEN]) == tg, bar);
            __builtin_amdgcn_fence(__ATOMIC_ACQUIRE, "agent");
            xb_add(&bar[XB_XGEN(b.x)], 1u);
            asm volatile("s_waitcnt vmcnt(0)" ::: "memory");
        } else {
            XB_SPIN(xb_ld(&bar[XB_XGEN(b.x)]) == gen, bar);
            __builtin_amdgcn_fence(__ATOMIC_ACQUIRE, "agent");
            asm volatile("s_waitcnt vmcnt(0)" ::: "memory");
        }
    }
    __syncthreads();
}

struct Args { const float* in[30]; float* out; unsigned char* ws; };
typedef const Args __attribute__((address_space(4)))* KArgs;
__device__ __forceinline__ KArgs kargs() { auto p = __builtin_amdgcn_kernarg_segment_ptr(); asm volatile("" : "+s"(p)); return (KArgs)p; }
using pg8::Unit; using pg8::cvt_pk_bf16;
template <int ACT> struct EpiGlu {
    static constexpr bool PERM = true, AFTER_DRAIN = false;
    bf16* O; int ldc; int col_off; int rssi;
    __device__ __forceinline__ void operator()(const f32x4 (&acc)[2][2][4][2], const Unit& u, int wr, int wc, int fr, int fq) const {
        const rss_t* rss = rssi >= 0 ? (const rss_t*)(kargs()->ws + WS_RSS) + (size_t)rssi * T : nullptr;
        const int row0 = u.pm * 256 + wr * 64 + fr; const int col0 = col_off + u.pn * 128 + wc * 16 + 4 * fq;
#pragma unroll
        for (int ai = 0; ai < 2; ++ai)
#pragma unroll
            for (int m = 0; m < 4; ++m) { const int row = row0 + ai * 128 + m * 16; bf16* rowp = O + (size_t)row * ldc + col0;
                const float rs = rss ? __builtin_amdgcn_rsqf((float)rss[row] * (RSS_INV / DM) + EPS) : 1.f;
#pragma unroll
                for (int bj = 0; bj < 2; ++bj) { const f32x4 a = acc[ai][bj][m][0] * rs, b = acc[ai][bj][m][1] * rs; f32x4 r;
#pragma unroll
                    for (int i = 0; i < 4; ++i) r[i] = (ACT == 0) ? a[i] * fsigmoid(a[i]) * b[i] : a[i] * fsigmoid(b[i]);
                    v2u w; w.x = cvt_pk_bf16(r[0], r[1]); w.y = cvt_pk_bf16(r[2], r[3]); *(v2u*)(rowp + bj * 64) = w; } }
    }
};
struct EpiSwiGlu {
    static constexpr bool PERM = true, AFTER_DRAIN = false;
    bf16* O; int ldc; int rssi;
    __device__ __forceinline__ void operator()(const f32x4 (&acc)[2][2][4][2], const Unit& u, int wr, int wc, int fr, int fq) const {
        const rss_t* rss = (const rss_t*)(kargs()->ws + WS_RSS) + (size_t)rssi * T;
        const int row0 = u.pm * 256 + wr * 64 + fr; const int col0 = u.pn * 128 + wc * 32 + 8 * fq;
#pragma unroll
        for (int ai = 0; ai < 2; ++ai)
#pragma unroll
            for (int m = 0; m < 4; ++m) { const int row = row0 + ai * 128 + m * 16;
                const float rs = __builtin_amdgcn_rsqf((float)rss[row] * (RSS_INV / DM) + EPS); const float rs2 = rs * rs, rsl = rs * -1.44269504089f;
                float r[8];
#pragma unroll
                for (int n = 0; n < 2; ++n) { const f32x4 a = acc[ai][0][m][n], b = acc[ai][1][m][n];
#pragma unroll
                    for (int i = 0; i < 4; ++i) r[4 * n + i] = (a[i] * b[i]) * rs2 * __builtin_amdgcn_rcpf(1.0f + __builtin_amdgcn_exp2f(a[i] * rsl)); }
                v4u w; w.x = cvt_pk_bf16(r[0], r[1]); w.y = cvt_pk_bf16(r[2], r[3]); w.z = cvt_pk_bf16(r[4], r[5]); w.w = cvt_pk_bf16(r[6], r[7]);
                *(v4u*)(O + (size_t)row * ldc + col0) = w; }
    }
};
struct EpiResid {
    static constexpr bool PERM = true, AFTER_DRAIN = false;
    int final_out; float s; int rssi;
    __device__ __forceinline__ void operator()(const f32x4 (&acc)[2][2][4][2], const Unit& u, int wr, int wc, int fr, int fq) const {
        KArgs ka = kargs(); bf16* xb = (bf16*)(ka->ws + WS_XN); float* xout = ka->out;
        rss_t* rss = (rss_t*)(ka->ws + WS_RSS) + (size_t)(rssi < 0 ? 0 : rssi) * T; const bool emit = rssi >= 0;
        const int row0 = u.pm * 256 + wr * 64 + fr; const int col0 = u.pn * 256 + wc * 32 + 8 * fq; const int lane = fq * 16 + fr;
#pragma unroll
        for (int ai = 0; ai < 2; ++ai)
#pragma unroll
            for (int m = 0; m < 4; ++m) { const int row = row0 + ai * 128 + m * 16; const size_t off = (size_t)row * DM + col0; float ss = 0.f;
#pragma unroll
                for (int bj = 0; bj < 2; ++bj) { const v4u xv = *(const v4u*)(xb + off + bj * 128);
                    const f32x4 y0 = (f32x4){bflo(xv.x), bfhi(xv.x), bflo(xv.y), bfhi(xv.y)} + acc[ai][bj][m][0] * s, y1 = (f32x4){bflo(xv.z), bfhi(xv.z), bflo(xv.w), bfhi(xv.w)} + acc[ai][bj][m][1] * s;
                    ss += ((y0.x * y0.x + y0.y * y0.y) + (y0.z * y0.z + y0.w * y0.w)) + ((y1.x * y1.x + y1.y * y1.y) + (y1.z * y1.z + y1.w * y1.w));
                    if (final_out) { *(f32x4*)(xout + off + bj * 128) = y0; *(f32x4*)(xout + off + bj * 128 + 4) = y1; }
                    else { v4u w; w.x = cvt_pk_bf16(y0.x, y0.y); w.y = cvt_pk_bf16(y0.z, y0.w); w.z = cvt_pk_bf16(y1.x, y1.y); w.w = cvt_pk_bf16(y1.z, y1.w); *(v4u*)(xb + off + bj * 128) = w; } }
                if (emit) { ss += shx(ss, 16, lane); ss += shx(ss, 32, lane); if (fq == 0) (void)__hip_atomic_fetch_add(rss + row, (rss_t)(ss * RSS_FIX), __ATOMIC_RELAXED, __HIP_MEMORY_SCOPE_AGENT); } }
    }
};
struct EpiIn {
    static constexpr bool PERM = true, AFTER_DRAIN = false;
    bf16 *AS5, *Q  , *ZG; unsigned char* G8; int rssi; const float* bgate;
    __device__ __forceinline__ void operator()(const f32x4 (&acc)[2][2][4][2], const Unit& u, int wr, int wc, int fr, int fq) const {
        const int row0 = u.pm * 256 + wr * 64 + fr; const int pn = u.pn; const int cl0 = wc * 32 + 8 * fq;
        const rss_t* rss = (const rss_t*)(kargs()->ws + WS_RSS) + (size_t)rssi * T;
        f32x4 bv[2][2];
        { const int ct = (pn >= 9 ? (pn - 9) * 256 : 0) + cl0;
#pragma unroll
          for (int bj = 0; bj < 2; ++bj)
#pragma unroll
            for (int n = 0; n < 2; ++n) bv[bj][n] = *(const f32x4*)(bgate + ct + bj * 128 + 4 * n); }
        float rsv[2][4];
#pragma unroll
        for (int ai = 0; ai < 2; ++ai)
#pragma unroll
            for (int m = 0; m < 4; ++m) rsv[ai][m] = __builtin_amdgcn_rsqf((float)rss[row0 + ai * 128 + m * 16] * (RSS_INV / DM) + EPS);
        if (pn == 0) {
#pragma unroll
            for (int ai = 0; ai < 2; ++ai)
#pragma unroll
                for (int m = 0; m < 4; ++m) { const float rs = rsv[ai][m]; const int t = row0 + ai * 128 + m * 16; const int b = t >> 12, c = (t >> 6) & 63, j = t & 63;
#pragma unroll
                    for (int bj = 0; bj < 2; ++bj) { const int col = cl0 + bj * 128; const int g = col >> 4, ci0 = col & 15;
                        const f32x4 v0 = (acc[ai][bj][m][0] * rs), v1 = (acc[ai][bj][m][1] * rs); v4u w; w.x = cvt_pk_bf16(v0[0], v0[1]); w.y = cvt_pk_bf16(v0[2], v0[3]); w.z = cvt_pk_bf16(v1[0], v1[1]); w.w = cvt_pk_bf16(v1[2], v1[3]);
                        *(v4u*)(AS5 + ((size_t)(g * 1024 + b * 64 + c) * AS5_LD + j * 16 + ci0)) = w; } }
        } else if (pn <= 6) {
            bf16* base = Q + (size_t)((pn - 1) >> 1) * ((size_t)T * 512); const int colt = ((pn - 1) & 1) * 256 + cl0;
#pragma unroll
            for (int ai = 0; ai < 2; ++ai)
#pragma unroll
                for (int m = 0; m < 4; ++m) { const float rs = rsv[ai][m]; bf16* rowp = base + (size_t)(row0 + ai * 128 + m * 16) * 512 + colt;
#pragma unroll
                    for (int bj = 0; bj < 2; ++bj) { const f32x4 v0 = (acc[ai][bj][m][0] * rs), v1 = (acc[ai][bj][m][1] * rs); v4u w; w.x = cvt_pk_bf16(v0[0], v0[1]); w.y = cvt_pk_bf16(v0[2], v0[3]); w.z = cvt_pk_bf16(v1[0], v1[1]); w.w = cvt_pk_bf16(v1[2], v1[3]);
                        *(v4u*)(rowp + bj * 128) = w; } }
        } else if (pn <= 8) {
            const int col0 = (pn - 7) * 128 + wc * 16 + 4 * fq;
#pragma unroll
            for (int ai = 0; ai < 2; ++ai)
#pragma unroll
                for (int m = 0; m < 4; ++m) { const float rs = rsv[ai][m]; bf16* rowp = ZG + (size_t)(row0 + ai * 128 + m * 16) * 256 + col0;
#pragma unroll
                    for (int bj = 0; bj < 2; ++bj) { const f32x4 a = (acc[ai][bj][m][0] * rs), b = (acc[ai][bj][m][1] * rs); f32x4 r;
#pragma unroll
                        for (int i = 0; i < 4; ++i) r[i] = a[i] * fsigmoid(b[i]);
                        v2u w; w.x = cvt_pk_bf16(r[0], r[1]); w.y = cvt_pk_bf16(r[2], r[3]); *(v2u*)(rowp + bj * 64) = w; } }
        } else {
            const int colt = (pn - 9) * 256 + cl0;
#pragma unroll
            for (int ai = 0; ai < 2; ++ai)
#pragma unroll
                for (int m = 0; m < 4; ++m) { const float rs = rsv[ai][m]; unsigned char* rowp = G8 + (size_t)(row0 + ai * 128 + m * 16) * 3072 + colt;
#pragma unroll
                    for (int bj = 0; bj < 2; ++bj) { const f32x4 v0 = (acc[ai][bj][m][0] * rs) + bv[bj][0], v1 = (acc[ai][bj][m][1] * rs) + bv[bj][1]; v2u w; w.x = 0u; w.y = 0u;
#pragma unroll
                        for (int i = 0; i < 4; ++i) { w.x = __builtin_amdgcn_cvt_pk_u8_f32(fsigmoid(v0[i]) * 255.0f, i, w.x); w.y = __builtin_amdgcn_cvt_pk_u8_f32(fsigmoid(v1[i]) * 255.0f, i, w.y); }
                        *(v2u*)(rowp + bj * 128) = w; } }
        }
    }
};
template <bool FIRST> struct EpiBranch {
    static constexpr bool PERM = true, AFTER_DRAIN = false;
    const bf16* G; bf16* MG; int br; const float* bgate;
    __device__ __forceinline__ void operator()(const f32x4 (&acc)[2][2][4][2], const Unit& u, int wr, int wc, int fr, int fq) const {
        const int row0 = u.pm * 256 + wr * 64 + fr; const int col0 = u.pn * 256 + wc * 32 + 8 * fq;
        f32x4 bv[2][2];
#pragma unroll
        for (int bj = 0; bj < 2; ++bj)
#pragma unroll
            for (int n = 0; n < 2; ++n) bv[bj][n] = *(const f32x4*)(bgate + br * 1024 + col0 + bj * 128 + 4 * n);
#pragma unroll
        for (int ai = 0; ai < 2; ++ai)
#pragma unroll
            for (int m = 0; m < 4; ++m) { const size_t r = (size_t)(row0 + ai * 128 + m * 16);
#pragma unroll
                for (int bj = 0; bj < 2; ++bj) { const v4u gw = *(const v4u*)(G + r * 3072 + br * 1024 + col0 + bj * 128); bf16* mp = MG + r * DM + col0 + bj * 128;
                    const f32x4 a0 = acc[ai][bj][m][0], a1 = acc[ai][bj][m][1]; const f32x4 b0 = bv[bj][0], b1 = bv[bj][1];
                    float o[8] = {a0[0] * fsigmoid(bflo(gw.x) + b0[0]), a0[1] * fsigmoid(bfhi(gw.x) + b0[1]), a0[2] * fsigmoid(bflo(gw.y) + b0[2]), a0[3] * fsigmoid(bfhi(gw.y) + b0[3]),
                                  a1[0] * fsigmoid(bflo(gw.z) + b1[0]), a1[1] * fsigmoid(bfhi(gw.z) + b1[1]), a1[2] * fsigmoid(bflo(gw.w) + b1[2]), a1[3] * fsigmoid(bfhi(gw.w) + b1[3])};
                    if (!FIRST) { const v4u pw = *(const v4u*)mp; o[0] += bflo(pw.x); o[1] += bfhi(pw.x); o[2] += bflo(pw.y); o[3] += bfhi(pw.y); o[4] += bflo(pw.z); o[5] += bfhi(pw.z); o[6] += bflo(pw.w); o[7] += bfhi(pw.w); }
                    v4u w; w.x = cvt_pk_bf16(o[0], o[1]); w.y = cvt_pk_bf16(o[2], o[3]); w.z = cvt_pk_bf16(o[4], o[5]); w.w = cvt_pk_bf16(o[6], o[7]); *(v4u*)mp = w; } }
    }
};
struct EpiBranchSeg {
    static constexpr bool PERM = true, AFTER_DRAIN = false;
    const unsigned char* G8; bf16* MG;
    __device__ __forceinline__ void operator()(const f32x4 (&acc)[2][2][4][2], const Unit& u, int wr, int wc, int fr, int fq) const {
        const int br = u.seg; const int row0 = u.pm * 256 + wr * 64 + fr; const int col0 = u.pn * 256 + wc * 32 + 8 * fq; const float k255 = 1.0f / 255.0f;
#pragma unroll
        for (int ai = 0; ai < 2; ++ai)
#pragma unroll
            for (int m = 0; m < 4; ++m) { const size_t r = (size_t)(row0 + ai * 128 + m * 16);
#pragma unroll
                for (int bj = 0; bj < 2; ++bj) { const v2u gw = *(const v2u*)(G8 + r * 3072 + br * 1024 + col0 + bj * 128); bf16* mp = MG + r * DM + col0 + bj * 128;
                    const f32x4 a0 = acc[ai][bj][m][0] * k255, a1 = acc[ai][bj][m][1] * k255;
                    float o[8] = {a0[0] * (float)(gw.x & 0xffu), a0[1] * (float)((gw.x >> 8) & 0xffu), a0[2] * (float)((gw.x >> 16) & 0xffu), a0[3] * (float)(gw.x >> 24),
                                  a1[0] * (float)(gw.y & 0xffu), a1[1] * (float)((gw.y >> 8) & 0xffu), a1[2] * (float)((gw.y >> 16) & 0xffu), a1[3] * (float)(gw.y >> 24)};
                    if (br != 0) { const v4u pw = *(const v4u*)mp; o[0] += bflo(pw.x); o[1] += bfhi(pw.x); o[2] += bflo(pw.y); o[3] += bfhi(pw.y); o[4] += bflo(pw.z); o[5] += bfhi(pw.z); o[6] += bflo(pw.w); o[7] += bfhi(pw.w); }
                    v4u w; w.x = cvt_pk_bf16(o[0], o[1]); w.y = cvt_pk_bf16(o[2], o[3]); w.z = cvt_pk_bf16(o[4], o[5]); w.w = cvt_pk_bf16(o[6], o[7]); *(v4u*)mp = w; } }
    }
};
struct BranchOrder { pg8::StaticOrder base;
    __device__ __forceinline__ bool next(int i, Unit& u) const { const int ti = i / 3, br = i - 3 * ti; if (!base.next(ti, u)) return false; u.seg = br; u.koff = br == 0 ? 0 : (br == 1 ? 256 : 768); u.nt = br == 1 ? 8 : 4; return true; }
    __device__ __forceinline__ void a_ready(const Unit&) const {} __device__ __forceinline__ void done(const Unit&) const {} };
struct EpiS5Y {
    static constexpr bool PERM = true, AFTER_DRAIN = false;
    bf16* S5G;
    __device__ __forceinline__ void operator()(const f32x4 (&acc)[2][2][4][2], const Unit& u, int wr, int wc, int fr, int fq) const {
        const int g = u.pm >> 2, rb = u.pm & 3, nb = u.pn - 5 * g;
        const int r0 = rb * 256 + wr * 64 + fr;
#pragma unroll
        for (int ai = 0; ai < 2; ++ai)
#pragma unroll
            for (int m = 0; m < 4; ++m) { const int r = r0 + ai * 128 + m * 16; const int b = r >> 6, c = r & 63;
#pragma unroll
                for (int bj = 0; bj < 2; ++bj) { const int col = nb * 256 + bj * 128 + wc * 32 + 8 * fq; const int i = col >> 4, co0 = col & 15;
                    const f32x4 v0 = acc[ai][bj][m][0], v1 = acc[ai][bj][m][1]; float o[8] = {v0[0], v0[1], v0[2], v0[3], v1[0], v1[1], v1[2], v1[3]};
#pragma unroll
                    for (int q = 0; q < 8; ++q) { const float x = o[q]; o[q] = x * fsigmoid(1.5957691216f * (x + 0.044715f * x * x * x)); }
                    v4u w; w.x = cvt_pk_bf16(o[0], o[1]); w.y = cvt_pk_bf16(o[2], o[3]); w.z = cvt_pk_bf16(o[4], o[5]); w.w = cvt_pk_bf16(o[6], o[7]);
                    *(v4u*)(S5G + ((size_t)(b * SEQ + c * 64 + i) * 256 + g * 16 + co0)) = w; } }
    }
};
struct EpiS5State {
    static constexpr bool PERM = false, AFTER_DRAIN = true;
    bf16* AS5; const f32x2* apow;
    __device__ __forceinline__ void operator()(const f32x4 (&)[2][2][4][2], const Unit&, int, int, int, int) const {}
    __device__ __forceinline__ void fused(f32x4 (&acc)[2][2][4][2], const Unit& u, int wr, int wc, int fr, int fq, PG8_LAS unsigned char* lds, int wid, int lane) const {
        PG8_LAS float* S = (PG8_LAS float*)lds;
        const int g = u.pm >> 2, rb = u.pm & 3;
#pragma unroll
        for (int ai = 0; ai < 2; ++ai)
#pragma unroll
            for (int m = 0; m < 4; ++m)
#pragma unroll
                for (int n = 0; n < 2; ++n) { const int r = ai * 128 + wr * 64 + m * 16 + fr; const int c = wc * 32 + n * 16 + 4 * fq; *(PG8_LAS f32x4*)(S + r * 132 + c) = acc[ai][0][m][n]; }
        asm volatile("s_waitcnt lgkmcnt(0)" ::: "memory"); __builtin_amdgcn_s_barrier(); asm volatile("" ::: "memory");
        const int tid = wid * 64 + lane;
        if (tid < 256) {
            const int bl = tid >> 6, p = tid & 63; const f32x2 a64 = apow[(g * 65 + 64) * 64 + p];
            float xr = 0.f, xi = 0.f; bf16* dst = AS5 + ((size_t)(g * 1024 + rb * 256 + bl * 64) * AS5_LD + 1024 + 2 * p);
            for (int c = 0; c < 64; ++c) { const f32x2 s = *(PG8_LAS f32x2*)(S + (bl * 64 + c) * 132 + 2 * p);
                *(unsigned*)(dst + (size_t)c * AS5_LD) = pk2(xr, xi);
                const float nr = a64.x * xr - a64.y * xi + s.x, ni = a64.x * xi + a64.y * xr + s.y; xr = nr; xi = ni; }
        }
    }
};
struct S5Order1 { int G, c; __device__ bool next(int i, Unit& u) const { const int L = i * G + c; if (L >= 64) return false; const int g = L >> 2, rb = L & 3; u.pm = g * 4 + rb; u.pn = g * 5 + 4; return true; }
    __device__ __forceinline__ void a_ready(const Unit&) const {} __device__ __forceinline__ void done(const Unit&) const {} };
struct S5Order2 { int G, c; __device__ bool next(int i, Unit& u) const { const int L = i * G + c; if (L >= 256) return false; const int g = L >> 4, rb = (L >> 2) & 3, nb = L & 3; u.pm = g * 4 + rb; u.pn = g * 5 + nb; return true; }
    __device__ __forceinline__ void a_ready(const Unit&) const {} __device__ __forceinline__ void done(const Unit&) const {} };

__device__ __forceinline__ void p0_transpose_item(const float* W, int ldw, int srcoff, int mode, int Hh, int Nsub, bf16* WT, int row_off, int ldt, int koff, LAS float* scr, int item, int lane, const float* gain = nullptr) {
    const int nblk = Nsub / 32, kb = item / nblk, nb = item % nblk, k0 = 64 * kb, n0 = 32 * nb;
    const int nn = n0 + (lane & 31); const int sc = srcoff + (mode == 1 ? (((nn & 7) >> 2) * Hh + (nn >> 3) * 4 + (nn & 3)) : mode == 2 ? ((((nn & 255) >> 7) * Hh) + (nn >> 8) * 128 + (nn & 127)) : nn);
    float wv[32];
#pragma unroll
    for (int i = 0; i < 32; ++i) wv[i] = W[(size_t)(k0 + 2 * i + (lane >> 5)) * ldw + sc];
    if (gain) {
#pragma unroll
        for (int i = 0; i < 32; ++i) wv[i] *= gain[k0 + 2 * i + (lane >> 5)]; }
#pragma unroll
    for (int i = 0; i < 32; ++i) scr[(2 * i + (lane >> 5)) * 33 + (lane & 31)] = wv[i];
    asm volatile("s_waitcnt lgkmcnt(0)" ::: "memory");
    const int c = lane & 7;
#pragma unroll
    for (int j = 0; j < 4; ++j) { const int n = (lane >> 3) + 8 * j; const LAS float* s = scr + (8 * c) * 33 + n;
        v4u o; o.x = pk2(s[0 * 33], s[1 * 33]); o.y = pk2(s[2 * 33], s[3 * 33]); o.z = pk2(s[4 * 33], s[5 * 33]); o.w = pk2(s[6 * 33], s[7 * 33]);
        *(v4u*)(WT + (size_t)(row_off + n0 + n) * ldt + koff + k0 + 8 * c) = o; }
    asm volatile("s_waitcnt lgkmcnt(0)" ::: "memory");
}
__device__ __forceinline__ void dsincos(double x, double& s, double& c) {
    const double k = __builtin_rint(x * 0.63661977236758134308);
    double r = __builtin_fma(-k, 1.57079632679489655800, x); r = __builtin_fma(-k, 6.12323399573676603587e-17, r);
    const double r2 = r * r;
    double sp = -1.0 / 1307674368000.0; sp = sp * r2 + 1.0 / 6227020800.0; sp = sp * r2 - 1.0 / 39916800.0; sp = sp * r2 + 1.0 / 362880.0; sp = sp * r2 - 1.0 / 5040.0; sp = sp * r2 + 1.0 / 120.0; sp = sp * r2 - 1.0 / 6.0; sp = sp * r2 + 1.0;
    const double sr = sp * r;
    double cp = 1.0 / 20922789888000.0; cp = cp * r2 - 1.0 / 87178291200.0; cp = cp * r2 + 1.0 / 479001600.0; cp = cp * r2 - 1.0 / 3628800.0; cp = cp * r2 + 1.0 / 40320.0; cp = cp * r2 - 1.0 / 720.0; cp = cp * r2 + 1.0 / 24.0; cp = cp * r2 - 0.5; cp = cp * r2 + 1.0;
    const int q = ((int)k) & 3;
    s = (q == 0) ? sr : (q == 1) ? cp : (q == 2) ? -sr : -cp;
    c = (q == 0) ? cp : (q == 1) ? -sr : (q == 2) ? -cp : sr;
}


__device__ __forceinline__ void rawnorm_phase(const float* x, bf16* XB, rss_t* rss, int wid_s) {
    unsigned z_ = 0u; asm volatile("" : "+v"(z_)); const int tid = wid_s * 64 + (int)__builtin_amdgcn_mbcnt_hi(~0u, __builtin_amdgcn_mbcnt_lo(~0u, z_)); const int wid = __builtin_amdgcn_readfirstlane(tid >> 6), lane = tid & 63;
    const int gw = blockIdx.x * NWAVES + wid, NGW = gridDim.x * NWAVES;
    for (int m = gw; m < T; m += 2 * NGW) {
        const int m1 = m + NGW;
        const f32x4* xr0 = (const f32x4*)(x + (size_t)m * DM) + lane; const f32x4* xr1 = (const f32x4*)(x + (size_t)m1 * DM) + lane; f32x4 v0[4], v1[4]; float s0 = 0.f, s1 = 0.f;
#pragma unroll
        for (int j = 0; j < 4; ++j) { v0[j] = xr0[64 * j]; v1[j] = xr1[64 * j]; }
#pragma unroll
        for (int j = 0; j < 4; ++j) { s0 += (v0[j].x * v0[j].x + v0[j].y * v0[j].y) + (v0[j].z * v0[j].z + v0[j].w * v0[j].w); s1 += (v1[j].x * v1[j].x + v1[j].y * v1[j].y) + (v1[j].z * v1[j].z + v1[j].w * v1[j].w); }
        s0 = wave_sum(s0, lane); s1 = wave_sum(s1, lane); if (lane == 0) { rss[m] = (rss_t)(s0 * RSS_FIX); rss[m1] = (rss_t)(s1 * RSS_FIX); }
        v2u* o0 = (v2u*)(XB + (size_t)m * DM) + lane; v2u* o1 = (v2u*)(XB + (size_t)m1 * DM) + lane;
#pragma unroll
        for (int j = 0; j < 4; ++j) { v2u w; w.x = pk2(v0[j].x, v0[j].y); w.y = pk2(v0[j].z, v0[j].w); o0[64 * j] = w; w.x = pk2(v1[j].x, v1[j].y); w.y = pk2(v1[j].z, v1[j].w); o1[64 * j] = w; }
    }
}

#define DPPF(v, ctrl) __builtin_bit_cast(float, __builtin_amdgcn_update_dpp(0, __builtin_bit_cast(int, (v)), (ctrl), 0xF, 0xF, true))
constexpr int ALD = 72;
__device__ __forceinline__ unsigned cvt_pk_nv(float lo, float hi) { unsigned r; asm("v_cvt_pk_bf16_f32 %0, %1, %2" : "=v"(r) : "v"(lo), "v"(hi)); return r; }
__device__ __forceinline__ void attn_phase(LAS unsigned char* lds, const bf16* Q, const bf16* K, const bf16* V, bf16* OB, const float* qg, const float* kg, const float* relb, int wid_s) {
    unsigned z_ = 0u; asm volatile("" : "+v"(z_)); const int tid = wid_s * 64 + (int)__builtin_amdgcn_mbcnt_hi(~0u, __builtin_amdgcn_mbcnt_lo(~0u, z_)); const int wid = __builtin_amdgcn_readfirstlane(tid >> 6), lane = tid & 63;
    const int fr = lane & 15, fq = lane >> 4;
    LAS bf16* Ks = (LAS bf16*)lds; LAS bf16* Vt = (LAS bf16*)(lds + 2 * 64 * ALD * 2); LAS float* biasS = (LAS float*)(lds + 4 * 64 * ALD * 2);
    const int skey = tid >> 3, spart = tid & 7;
    const int vwcol = skey ^ (spart << 3), vrcol = (fq * 4) ^ ((fr >> 3) << 3);
    float kgv[8];
#pragma unroll
    for (int i = 0; i < 8; ++i) kgv[i] = kg[spart * 8 + i];
    float qgv[2][8];
#pragma unroll
    for (int ks = 0; ks < 2; ++ks)
#pragma unroll
        for (int i = 0; i < 8; ++i) qgv[ks][i] = qg[ks * 32 + fq * 8 + i] * (0.125f * 1.44269504089f);
    v4u krA = (v4u){0u, 0u, 0u, 0u}, vrA = krA, krB = krA, vrB = krA, nq0 = krA, nq1 = krA; float nbias = 0.f; bool pre = false;
    for (int u = blockIdx.x; u < 4096; u += gridDim.x) {
        const int h = u & 7, cp = (u >> 3) & 31, b = u >> 8;
        const int un = u + gridDim.x; const bool has_next = un < 4096; const int hn = un & 7, cpn = (un >> 3) & 31, bn = un >> 8; const int jt0n = (8 - 2 * cpn) > 0 ? (8 - 2 * cpn) : 0;
        const size_t kvbase_n = ((size_t)bn * SEQ + (size_t)(2 * cpn - 8) * 64 + skey) * 512 + hn * 64 + spart * 8;
        const size_t qoff_n = ((size_t)bn * SEQ + (2 * cpn + (wid >> 2)) * 64 + (wid & 3) * 16 + fr) * 512 + hn * 64 + fq * 8;
        const int c = 2 * cp + (wid >> 2); const size_t qrow = (size_t)b * SEQ + c * 64 + (wid & 3) * 16 + fr;
        if (tid < 257) biasS[tid] = (pre ? nbias : relb[h * 257 + tid]) * 1.44269504089f;
        bf16x8 Qb[2];
        { v4u raw[2]; float f[2][8]; float ss = 0.f;
#pragma unroll
            for (int ks = 0; ks < 2; ++ks) { raw[ks] = pre ? (ks ? nq1 : nq0) : *(const v4u*)(Q + qrow * 512 + h * 64 + ks * 32 + fq * 8);
                f[ks][0] = bflo(raw[ks].x); f[ks][1] = bfhi(raw[ks].x); f[ks][2] = bflo(raw[ks].y); f[ks][3] = bfhi(raw[ks].y); f[ks][4] = bflo(raw[ks].z); f[ks][5] = bfhi(raw[ks].z); f[ks][6] = bflo(raw[ks].w); f[ks][7] = bfhi(raw[ks].w);
#pragma unroll
                for (int i = 0; i < 8; ++i) ss += f[ks][i] * f[ks][i]; }
            ss += shx(ss, 16, lane); ss += shx(ss, 32, lane);
            const float rq = 1.0f / sqrtf(ss * (1.f / 64.f) + EPS);
#pragma unroll
            for (int ks = 0; ks < 2; ++ks) { v4u w; w.x = pk2(f[ks][0] * rq * qgv[ks][0], f[ks][1] * rq * qgv[ks][1]); w.y = pk2(f[ks][2] * rq * qgv[ks][2], f[ks][3] * rq * qgv[ks][3]);
                w.z = pk2(f[ks][4] * rq * qgv[ks][4], f[ks][5] * rq * qgv[ks][5]); w.w = pk2(f[ks][6] * rq * qgv[ks][6], f[ks][7] * rq * qgv[ks][7]); Qb[ks] = __builtin_bit_cast(bf16x8, w); } }
        f32x4 o[4];
#pragma unroll
        for (int d = 0; d < 4; ++d) o[d] = (f32x4){0.f, 0.f, 0.f, 0.f};
        float lsum = 0.f;
        const int jt0 = (8 - 2 * cp) > 0 ? (8 - 2 * cp) : 0;
        const size_t kvbase = ((size_t)b * SEQ + (size_t)(2 * cp - 8) * 64 + skey) * 512 + h * 64 + spart * 8;
#define ATT_LOAD(KR, VR, JT) do { KR = *(const v4u*)(K + kvbase + (size_t)(JT) * 64 * 512); VR = *(const v4u*)(V + kvbase + (size_t)(JT) * 64 * 512); } while (0)
#define ATT_STAGE(KR, VR, BUF) do { \
            { float f[8] = {bflo(KR.x), bfhi(KR.x), bflo(KR.y), bfhi(KR.y), bflo(KR.z), bfhi(KR.z), bflo(KR.w), bfhi(KR.w)}; float ss = 0.f; \
                _Pragma("unroll") for (int i = 0; i < 8; ++i) ss += f[i] * f[i]; \
                ss += DPPF(ss, 0xB1); ss += DPPF(ss, 0x4E); ss += DPPF(ss, 0x141);     \
                const float rk = __builtin_amdgcn_rsqf(ss * (1.f / 64.f) + EPS); \
                v4u w; w.x = cvt_pk_nv(f[0] * rk * kgv[0], f[1] * rk * kgv[1]); w.y = cvt_pk_nv(f[2] * rk * kgv[2], f[3] * rk * kgv[3]); w.z = cvt_pk_nv(f[4] * rk * kgv[4], f[5] * rk * kgv[5]); w.w = cvt_pk_nv(f[6] * rk * kgv[6], f[7] * rk * kgv[7]); \
                *(LAS v4u*)(Ks + (BUF) * 64 * ALD + skey * ALD + spart * 8) = w; } \
            { LAS bf16* vp = Vt + (BUF) * 64 * ALD + (spart * 8) * ALD + vwcol; \
                vp[0 * ALD] = (bf16)(VR.x & 0xffffu); vp[1 * ALD] = (bf16)(VR.x >> 16); vp[2 * ALD] = (bf16)(VR.y & 0xffffu); vp[3 * ALD] = (bf16)(VR.y >> 16); \
                vp[4 * ALD] = (bf16)(VR.z & 0xffffu); vp[5 * ALD] = (bf16)(VR.z >> 16); vp[6 * ALD] = (bf16)(VR.w & 0xffffu); vp[7 * ALD] = (bf16)(VR.w >> 16); } } while (0)
#define ATT_BAR() do { asm volatile("s_waitcnt lgkmcnt(0)" ::: "memory"); __builtin_amdgcn_s_barrier(); asm volatile("" ::: "memory"); } while (0)
#define ATT_COMPUTE(JT, BUF) do { const int dt = c - (2 * cp - 8 + (JT)); \
            if (dt >= 0 && dt <= 8) { \
                f32x4 s[4]; \
                _Pragma("unroll") for (int blk = 0; blk < 4; ++blk) { s[blk] = (f32x4){0.f, 0.f, 0.f, 0.f}; \
                    _Pragma("unroll") for (int ks = 0; ks < 2; ++ks) { const bf16x8 a = *(const LAS bf16x8*)(Ks + (BUF) * 64 * ALD + (blk * 16 + fr) * ALD + ks * 32 + fq * 8); s[blk] = __builtin_amdgcn_mfma_f32_16x16x32_bf16(a, Qb[ks], s[blk], 0, 0, 0); } } \
                if (dt >= 3) { const float bc = biasS[256]; \
                    _Pragma("unroll") for (int blk = 0; blk < 4; ++blk) _Pragma("unroll") for (int j = 0; j < 4; ++j) s[blk][j] = __builtin_amdgcn_exp2f(s[blk][j] + bc); \
                } else { const int dbase = dt * 64 + (wid & 3) * 16 + fr - fq * 4; \
                    _Pragma("unroll") for (int blk = 0; blk < 4; ++blk) _Pragma("unroll") for (int j = 0; j < 4; ++j) { int d = dbase - blk * 16 - j; d = d > 128 ? 128 : d; s[blk][j] = __builtin_amdgcn_exp2f(s[blk][j] + biasS[d + 128]); } } \
                bf16x8 Pb[2]; \
                _Pragma("unroll") for (int ks = 0; ks < 2; ++ks) { const f32x4 p0 = s[2 * ks], p1 = s[2 * ks + 1]; lsum += (p0[0] + p0[1]) + (p0[2] + p0[3]) + (p1[0] + p1[1]) + (p1[2] + p1[3]); \
                    v4u w; w.x = cvt_pk_nv(p0[0], p0[1]); w.y = cvt_pk_nv(p0[2], p0[3]); w.z = cvt_pk_nv(p1[0], p1[1]); w.w = cvt_pk_nv(p1[2], p1[3]); Pb[ks] = __builtin_bit_cast(bf16x8, w); } \
                _Pragma("unroll") for (int db = 0; db < 4; ++db) _Pragma("unroll") for (int ks = 0; ks < 2; ++ks) { const LAS bf16* vr = Vt + (BUF) * 64 * ALD + (db * 16 + fr) * ALD + vrcol; \
                        const v2u lo = *(const LAS v2u*)(vr + (((2 * ks) ^ db) << 4)), hi = *(const LAS v2u*)(vr + (((2 * ks + 1) ^ db) << 4));     \
                        v4u w; w.x = lo.x; w.y = lo.y; w.z = hi.x; w.w = hi.y; \
                        o[db] = __builtin_amdgcn_mfma_f32_16x16x32_bf16(__builtin_bit_cast(bf16x8, w), Pb[ks], o[db], 0, 0, 0); } \
            } } while (0)
#define ATT_LOADN(KR, VR, JT) do { KR = *(const v4u*)(K + kvbase_n + (size_t)(JT) * 64 * 512); VR = *(const v4u*)(V + kvbase_n + (size_t)(JT) * 64 * 512); } while (0)
        if (!pre) { ATT_LOAD(krA, vrA, jt0); ATT_LOAD(krB, vrB, jt0 + 1); }
        ATT_STAGE(krA, vrA, 0);
        if (jt0 + 2 < 10) ATT_LOAD(krA, vrA, jt0 + 2); else if (has_next) ATT_LOADN(krA, vrA, jt0n);
        ATT_BAR();
        for (int jt = jt0; jt < 10; jt += 2) {
            ATT_STAGE(krB, vrB, 1);
            if (jt + 3 < 10) ATT_LOAD(krB, vrB, jt + 3);
            else if (has_next) { ATT_LOADN(krB, vrB, jt0n + 1); nq0 = *(const v4u*)(Q + qoff_n); nq1 = *(const v4u*)(Q + qoff_n + 32); if (tid < 257) nbias = relb[hn * 257 + tid]; }
            ATT_COMPUTE(jt, 0);
            ATT_BAR();
            if (jt + 2 < 10) { ATT_STAGE(krA, vrA, 0); if (jt + 4 < 10) ATT_LOAD(krA, vrA, jt + 4); else if (has_next) ATT_LOADN(krA, vrA, jt0n); }
            ATT_COMPUTE(jt + 1, 1);
            ATT_BAR();
        }
#undef ATT_LOAD
#undef ATT_LOADN
#undef ATT_STAGE
#undef ATT_BAR
#undef ATT_COMPUTE
        lsum += shx(lsum, 16, lane); lsum += shx(lsum, 32, lane);
        const float inv = 1.0f / lsum;
        bf16* op = OB + qrow * DM + 256 + h * 64 + fq * 4;
#pragma unroll
        for (int db = 0; db < 4; ++db) { v2u w; w.x = pk2(o[db][0] * inv, o[db][1] * inv); w.y = pk2(o[db][2] * inv, o[db][3] * inv); *(v2u*)(op + db * 16) = w; }
        pre = has_next;
        asm volatile("s_waitcnt lgkmcnt(0)" ::: "memory"); __builtin_amdgcn_s_barrier(); asm volatile("" ::: "memory");
    }
    __syncthreads();
}

__device__ __forceinline__ void conv_phase(LAS unsigned char* lds, const bf16* ZG, bf16* OB, const float* wdw, const float* bdw, const float* lng, const float* lnb, int wid_s) {
    unsigned z_ = 0u; asm volatile("" : "+v"(z_)); const int tid = wid_s * 64 + (int)__builtin_amdgcn_mbcnt_hi(~0u, __builtin_amdgcn_mbcnt_lo(~0u, z_)); const int wid = __builtin_amdgcn_readfirstlane(tid >> 6), lane = tid & 63;
    LAS float* wS = (LAS float*)lds; LAS float* xS = (LAS float*)(lds + 32768);
    for (int i = tid; i < 31 * 256; i += 512) wS[i] = wdw[i];
    const f32x4 bias4 = ((const f32x4*)bdw)[lane], g4 = ((const f32x4*)lng)[lane], b4 = ((const f32x4*)lnb)[lane];
    for (int tile = blockIdx.x; tile < 1024; tile += gridDim.x) {
        const int b = tile >> 6, tin = (tile & 63) * 64;
        __syncthreads();
        for (int i = tid; i < 94 * 32; i += 512) { const int r = i >> 5, pc = i & 31; const int pos = tin - 30 + r; v4u v = (v4u){0u, 0u, 0u, 0u};
            if (pos >= 0) v = *(const v4u*)(ZG + ((size_t)b * SEQ + pos) * 256 + pc * 8);
            LAS f32x4* d = (LAS f32x4*)(xS + r * 256 + pc * 8); d[0] = (f32x4){bflo(v.x), bfhi(v.x), bflo(v.y), bfhi(v.y)}; d[1] = (f32x4){bflo(v.z), bfhi(v.z), bflo(v.w), bfhi(v.w)}; }
        __syncthreads();
        f32x4 acc[8];
#pragma unroll
        for (int j = 0; j < 8; ++j) acc[j] = bias4;
        const LAS float* xb = xS + (wid * 8) * 256 + lane * 4;
        for (int k = 0; k < 31; ++k) { const f32x4 w = *(const LAS f32x4*)(wS + k * 256 + lane * 4);
#pragma unroll
            for (int j = 0; j < 8; ++j) { const f32x4 x = *(const LAS f32x4*)(xb + (j + k) * 256); acc[j] += x * w; } }
#pragma unroll
        for (int j = 0; j < 8; ++j) { const int tok = wid * 8 + j; const f32x4 a4 = acc[j];
            const float mu = wave_sum((a4.x + a4.y) + (a4.z + a4.w), lane) * (1.f / 256.f); const f32x4 d = a4 - mu;
            const float var = wave_sum((d.x * d.x + d.y * d.y) + (d.z * d.z + d.w * d.w), lane) * (1.f / 256.f); const float rstd = 1.0f / sqrtf(var + EPS);
            f32x4 y = d * rstd * g4 + b4; y.x *= fsigmoid(y.x); y.y *= fsigmoid(y.y); y.z *= fsigmoid(y.z); y.w *= fsigmoid(y.w);
            v2u w; w.x = pk2(y.x, y.y); w.y = pk2(y.z, y.w); *(v2u*)(OB + ((size_t)b * SEQ + tin + tok) * DM + 768 + lane * 4) = w; }
    }
    __syncthreads();
}

#define WSP(T_, off) ((T_*)(ka->ws + (off)))
__global__ void __launch_bounds__(NWAVES * 64, 2) fwd_megakernel(Args args_unused) {
    extern __shared__ __attribute__((aligned(16))) unsigned char lds_raw[];
    cg::grid_group grid = cg::this_grid();
    LAS unsigned char* lds = (LAS unsigned char*)lds_raw;
#define GRID_SYNC() do { unsigned z__ = 0u; asm volatile("" : "+v"(z__)); const bool ld__ = (wid_s == 0) && (__builtin_amdgcn_mbcnt_hi(~0u, __builtin_amdgcn_mbcnt_lo(~0u, z__)) == 0u); \
        XcdBarrier xb__ = xbar; asm volatile("" : "+s"(xb__.bar)); xcd_barrier(xb__, ld__);     } while (0)
    const int wid_s = __builtin_amdgcn_readfirstlane((int)threadIdx.x >> 6);
    if (threadIdx.x < 16) ((LAS unsigned*)(lds + LDS_BYTES - 64))[threadIdx.x] = 0u;
    __syncthreads();
    grid.sync();
    XcdBarrier xbar = xcd_barrier_post((unsigned*)(kargs()->ws), (volatile LAS unsigned*)(lds + LDS_BYTES - 64), threadIdx.x == 0);

    {
        KArgs ka = kargs(); unsigned char* ws = ka->ws;
        unsigned z_ = 0u; asm volatile("" : "+v"(z_)); const int tid = wid_s * 64 + (int)__builtin_amdgcn_mbcnt_hi(~0u, __builtin_amdgcn_mbcnt_lo(~0u, z_)); const int wid = __builtin_amdgcn_readfirstlane(tid >> 6), lane = tid & 63;
        const int G = gridDim.x, cu = blockIdx.x; const int gtid = cu * 512 + tid;
        LAS float* scr = (LAS float*)(lds + wid * 16384);
        const int gw = cu * NWAVES + wid, NGW = G * NWAVES;
        constexpr int I_UP = 16 * 176, I_DN = 44 * 32, I_INA = 16 * 56, I_INB = 16 * 16, I_INC = 16 * 96, I_GLU = 4 * 16, I_BS = 4 * 32, I_BA = 8 * 32, I_BC = 4 * 32, I_OUT = 16 * 32;
        constexpr int PER_L = 2 * I_UP + 2 * I_DN + I_INA + I_INB + I_INC + I_GLU + I_BS + I_BA + I_BC + I_OUT;
        for (int it = gw; it < 2 * PER_L; it += NGW) {
            const int l = it >= PER_L ? 1 : 0; int r = it - l * PER_L;
            unsigned char* wl = ws + WS_W + (size_t)l * W_LSTRIDE;
            if (r < I_UP) { p0_transpose_item(ka->in[2] + (size_t)l * DM * NUP, NUP, 0, 2, FF, NUP, (bf16*)(wl + WO_UP1), 0, DM, 0, scr, r, lane, ka->in[1] + l * DM); continue; } r -= I_UP;
            if (r < I_DN) { p0_transpose_item(ka->in[3] + (size_t)l * FF * DM, DM, 0, 0, 0, DM, (bf16*)(wl + WO_DN1), 0, FF, 0, scr, r, lane); continue; } r -= I_DN;
            if (r < I_INA) { p0_transpose_item(ka->in[5] + (size_t)l * DM * INC, INC, 0, 0, 0, 1792, (bf16*)(wl + WO_IN), 0, DM, 0, scr, r, lane, ka->in[4] + l * DM); continue; } r -= I_INA;
            if (r < I_INB) { p0_transpose_item(ka->in[5] + (size_t)l * DM * INC, INC, 1792, 1, 256, 512, (bf16*)(wl + WO_IN), 1792, DM, 0, scr, r, lane, ka->in[4] + l * DM); continue; } r -= I_INB;
            if (r < I_INC) { p0_transpose_item(ka->in[5] + (size_t)l * DM * INC, INC, 2304, 0, 0, 3072, (bf16*)(wl + WO_IN), 2304, DM, 0, scr, r, lane, ka->in[4] + l * DM); continue; } r -= I_INC;
            if (r < I_GLU) { p0_transpose_item(ka->in[15] + (size_t)l * 256 * 512, 512, 0, 1, 256, 512, (bf16*)(wl + WO_GLU), 0, 256, 0, scr, r, lane); continue; } r -= I_GLU;
            if (r < I_BS) { p0_transpose_item(ka->in[16] + (size_t)l * 256 * DM, DM, 0, 0, 0, DM, (bf16*)(wl + WO_BR), 0, DM, 0, scr, r, lane); continue; } r -= I_BS;
            if (r < I_BA) { p0_transpose_item(ka->in[20] + (size_t)l * 512 * DM, DM, 0, 0, 0, DM, (bf16*)(wl + WO_BR), 0, DM, 256, scr, r, lane); continue; } r -= I_BA;
            if (r < I_BC) { p0_transpose_item(ka->in[25] + (size_t)l * 256 * DM, DM, 0, 0, 0, DM, (bf16*)(wl + WO_BR), 0, DM, 768, scr, r, lane); continue; } r -= I_BC;
            if (r < I_OUT) { p0_transpose_item(ka->in[26] + (size_t)l * DM * DM, DM, 0, 0, 0, DM, (bf16*)(wl + WO_OUT), 0, DM, 0, scr, r, lane); continue; } r -= I_OUT;
            if (r < I_UP) { p0_transpose_item(ka->in[28] + (size_t)l * DM * NUP, NUP, 0, 2, FF, NUP, (bf16*)(wl + WO_UP2), 0, DM, 0, scr, r, lane, ka->in[27] + l * DM); continue; } r -= I_UP;
            p0_transpose_item(ka->in[29] + (size_t)l * FF * DM, DM, 0, 0, 0, DM, (bf16*)(wl + WO_DN2), 0, FF, 0, scr, r, lane);
        }
        { rss_t* rz = (rss_t*)(ws + WS_RSS) + T; for (int i = gtid; i < 5 * T; i += G * 512) rz[i] = 0ull; }
        rawnorm_phase(ka->in[0], (bf16*)(ws + WS_XN), (rss_t*)(ws + WS_RSS), wid_s);
        if (gtid < 2048) {
            f32x2* APOW = (f32x2*)(ws + WS_APOW); f32x2* BBAR = (f32x2*)(ws + WS_BBAR);
            const int lg = gtid >> 6, p = gtid & 63;
            const float lre = fminf(ka->in[7][gtid], -1e-4f), lim = ka->in[8][gtid], dt = expf(ka->in[9][lg]);
            const float mag = expf(lre * dt), ang = lim * dt; double sd, cd; dsincos((double)ang, sd, cd);
            const float ar = mag * (float)cd, ai = mag * (float)sd;
            const float den = lre * lre + lim * lim; const float cr = ((ar - 1.0f) * lre + ai * lim) / den, ci = (ai * lre - (ar - 1.0f) * lim) / den;
            for (int c = 0; c < 16; ++c) { const float br = ka->in[10][(size_t)gtid * 16 + c], bi = ka->in[11][(size_t)gtid * 16 + c]; BBAR[(size_t)gtid * 16 + c] = (f32x2){cr * br - ci * bi, cr * bi + ci * br}; }
            double pr = 1.0, pi = 0.0; const double dar = (double)mag * cd, dai = (double)mag * sd;
            for (int lag = 0; lag <= 64; ++lag) { APOW[((size_t)lg * 65 + lag) * 64 + p] = (f32x2){(float)pr, (float)pi}; const double nr = pr * dar - pi * dai, ni = pr * dai + pi * dar; pr = nr; pi = ni; }
        }
    }
    GRID_SYNC();
#define RSS(j) ((float*)(ka->ws + WS_RSS) + (size_t)(j) * T)
#define WL(off) ((const bf16*)(ka->ws + WS_W + (size_t)l * W_LSTRIDE + (off)))
#pragma nounroll
    for (int l = 0; l < 2; ++l) {
        if (l == 0) {
    {
        KArgs ka = kargs(); unsigned char* ws = ka->ws; const f32x2* APOW = (const f32x2*)(ws + WS_APOW); const f32x2* BBAR = (const f32x2*)(ws + WS_BBAR); float* KMAT = (float*)(ws + WS_KMAT);
        unsigned z_ = 0u; asm volatile("" : "+v"(z_)); const int tid = wid_s * 64 + (int)__builtin_amdgcn_mbcnt_hi(~0u, __builtin_amdgcn_mbcnt_lo(~0u, z_)); const int gtid = blockIdx.x * 512 + tid, NT = gridDim.x * 512;
#pragma unroll 2
        for (int it = gtid; it < 2 * 16 * 64 * 256; it += NT) {
            const int ci = it & 15, co = (it >> 4) & 15, lag = (it >> 8) & 63, lg = it >> 14;
            const float* cre = ka->in[12] + ((size_t)lg * 16 + co) * 64; const float* cim = ka->in[13] + ((size_t)lg * 16 + co) * 64;
            const f32x2* ap = APOW + ((size_t)lg * 65 + lag) * 64; const f32x2* bb = BBAR + (size_t)lg * 64 * 16 + ci;
            float s = 0.f;
#pragma unroll 8
            for (int p = 0; p < 64; ++p) { const f32x2 a = ap[p], b = bb[p * 16]; const float wr_ = a.x * b.x - a.y * b.y, wi_ = a.x * b.y + a.y * b.x; s += cre[p] * wr_ - cim[p] * wi_; }
            if (lag == 0 && co == ci) s += ka->in[14][lg * 16 + co];
            KMAT[it] = s;
        }
    }
            }
        { KArgs ka = kargs(); const int G = gridDim.x, cu = blockIdx.x;
          pg8::Gemm g{WSP(bf16, WS_XN), WL(WO_UP1), T, NUP, DM, DM, DM}; pg8::StaticOrder S; S.init(T, NUP, G, cu); EpiSwiGlu E{WSP(bf16, WS_H), FF, l * 3 + 0};
          pg8::gemm_phase<EpiSwiGlu, pg8::StaticOrder, true, true>(lds, g, S, E, wid_s); }
        GRID_SYNC();
        if (l == 0) {
    {
        KArgs ka = kargs(); unsigned char* ws = ka->ws; const f32x2* APOW = (const f32x2*)(ws + WS_APOW); const f32x2* BBAR = (const f32x2*)(ws + WS_BBAR); const float* KMAT = (const float*)(ws + WS_KMAT);
        unsigned z_ = 0u; asm volatile("" : "+v"(z_)); const int tid = wid_s * 64 + (int)__builtin_amdgcn_mbcnt_hi(~0u, __builtin_amdgcn_mbcnt_lo(~0u, z_)); const int gtid = blockIdx.x * 512 + tid, NT = gridDim.x * 512;
#pragma unroll 2
        for (int it = gtid; it < 2 * 16 * BS5_ROWS * 144; it += NT) {
            const int k8 = it % 144; const int n = (it / 144) % BS5_ROWS; const int lg = it / (144 * BS5_ROWS); const int l = lg >> 4, g = lg & 15;
            float v[8];
#pragma unroll
            for (int q = 0; q < 8; ++q) v[q] = 0.f;
            if (n < 1024) { const int i = n >> 4, co = n & 15;
                if (k8 < 128) { const int j = k8 >> 1, ci0 = (k8 & 1) * 8;
                    if (j <= i) { const f32x4* kp = (const f32x4*)(KMAT + (((size_t)lg * 64 + (i - j)) * 16 + co) * 16 + ci0); const f32x4 a = kp[0], b = kp[1]; v[0] = a.x; v[1] = a.y; v[2] = a.z; v[3] = a.w; v[4] = b.x; v[5] = b.y; v[6] = b.z; v[7] = b.w; }
                } else { const int p0 = (k8 - 128) * 4;
#pragma unroll
                    for (int q = 0; q < 4; ++q) { const int p = p0 + q; const float cre = ka->in[12][((size_t)lg * 16 + co) * 64 + p], cim = ka->in[13][((size_t)lg * 16 + co) * 64 + p]; const f32x2 a = APOW[((size_t)lg * 65 + i + 1) * 64 + p];
                        v[2 * q] = cre * a.x - cim * a.y; v[2 * q + 1] = -(cre * a.y + cim * a.x); } }
            } else if (n < 1152) { const int s = n & 1, p = (n - 1024) >> 1;
                if (k8 < 128) { const int j = k8 >> 1, ci0 = (k8 & 1) * 8; const f32x2 a = APOW[((size_t)lg * 65 + 63 - j) * 64 + p];
#pragma unroll
                    for (int q = 0; q < 8; ++q) { const f32x2 b = BBAR[((size_t)lg * 64 + p) * 16 + ci0 + q]; v[q] = s ? (a.x * b.y + a.y * b.x) : (a.x * b.x - a.y * b.y); } }
            }
            v4u w; w.x = pk2(v[0], v[1]); w.y = pk2(v[2], v[3]); w.z = pk2(v[4], v[5]); w.w = pk2(v[6], v[7]);
            *(v4u*)((bf16*)(ws + WS_W + (size_t)l * W_LSTRIDE + WO_BS5) + ((size_t)(g * BS5_ROWS + n) * AS5_LD + k8 * 8)) = w;
        }
    }
            }
        { KArgs ka = kargs(); const int G = gridDim.x, cu = blockIdx.x;
          pg8::Gemm g{WSP(bf16, WS_H), WL(WO_DN1), T, DM, FF, FF, FF}; pg8::StaticOrder S; S.init(T, DM, G, cu); EpiResid E{0, 0.5f, l * 3 + 1};
          pg8::gemm_phase<EpiResid, pg8::StaticOrder, true, true>(lds, g, S, E, wid_s); }
        GRID_SYNC();
        { KArgs ka = kargs(); const int G = gridDim.x, cu = blockIdx.x;
          pg8::Gemm g{WSP(bf16, WS_XN), WL(WO_IN), T, INC, DM, DM, DM}; pg8::StaticOrder S; S.init(T, INC, G, cu);
          EpiIn E{WSP(bf16, WS_AS5), WSP(bf16, WS_Q), WSP(bf16, WS_ZG), (unsigned char*)(ka->ws + WS_G), l * 3 + 1, ka->in[6] + l * 3072};
          pg8::gemm_phase<EpiIn, pg8::StaticOrder, true, true>(lds, g, S, E, wid_s); }
        GRID_SYNC();
        { KArgs ka = kargs(); const int G = gridDim.x, cu = blockIdx.x;
          pg8::Gemm g{WSP(bf16, WS_AS5), WL(WO_BS5), 16 * 1024, 16 * BS5_ROWS, 1024, AS5_LD, AS5_LD}; S5Order1 S{G, cu}; EpiS5State E{WSP(bf16, WS_AS5), WSP(const f32x2, WS_APOW) + (size_t)l * 16 * 65 * 64};
          pg8::gemm_phase<EpiS5State, S5Order1, false, true>(lds, g, S, E, wid_s); }
        __syncthreads();
        { KArgs ka = kargs(); attn_phase(lds, WSP(bf16, WS_Q), WSP(bf16, WS_K), WSP(bf16, WS_V), (bf16*)ka->out, ka->in[17] + l * 64, ka->in[18] + l * 64, ka->in[19] + l * 8 * 257, wid_s); }
        { KArgs ka = kargs(); conv_phase(lds, WSP(bf16, WS_ZG), (bf16*)ka->out, ka->in[21] + l * 31 * 256, ka->in[22] + l * 256, ka->in[23] + l * 256, ka->in[24] + l * 256, wid_s); }
        GRID_SYNC();
        { KArgs ka = kargs(); const int G = gridDim.x, cu = blockIdx.x;
          pg8::Gemm g{WSP(bf16, WS_AS5), WL(WO_BS5), 16 * 1024, 16 * BS5_ROWS, AS5_LD, AS5_LD, AS5_LD}; S5Order2 S{G, cu}; EpiS5Y E{WSP(bf16, WS_ZG)};
          pg8::gemm_phase<EpiS5Y, S5Order2, true, true>(lds, g, S, E, wid_s); }
        GRID_SYNC();
        { KArgs ka = kargs(); const int G = gridDim.x, cu = blockIdx.x;
          pg8::Gemm g{WSP(bf16, WS_ZG), WL(WO_GLU), T, 512, 256, 256, 256}; pg8::StaticOrder S; S.init(T, 512, G, cu); EpiGlu<1> E{(bf16*)ka->out, DM, 0, -1};
          pg8::gemm_phase<EpiGlu<1>, pg8::StaticOrder, true, true>(lds, g, S, E, wid_s); }
        GRID_SYNC();
        { KArgs ka = kargs(); const int G = gridDim.x, cu = blockIdx.x;
          pg8::Gemm g{(const bf16*)ka->out, WL(WO_BR), T, DM, DM, DM, DM}; BranchOrder S; S.base.init(T, DM, G, cu); EpiBranchSeg E{(const unsigned char*)(ka->ws + WS_G), WSP(bf16, WS_MG)};
          pg8::gemm_phase<EpiBranchSeg, BranchOrder, true, true>(lds, g, S, E, wid_s); }
        GRID_SYNC();
        { KArgs ka = kargs(); const int G = gridDim.x, cu = blockIdx.x;
          pg8::Gemm g{WSP(bf16, WS_MG), WL(WO_OUT), T, DM, DM, DM, DM}; pg8::StaticOrder S; S.init(T, DM, G, cu); EpiResid E{0, 1.0f, l * 3 + 2};
          pg8::gemm_phase<EpiResid, pg8::StaticOrder, true, true>(lds, g, S, E, wid_s); }
        GRID_SYNC();
        { KArgs ka = kargs(); const int G = gridDim.x, cu = blockIdx.x;
          pg8::Gemm g{WSP(bf16, WS_XN), WL(WO_UP2), T, NUP, DM, DM, DM}; pg8::StaticOrder S; S.init(T, NUP, G, cu); EpiSwiGlu E{WSP(bf16, WS_H), FF, l * 3 + 2};
          pg8::gemm_phase<EpiSwiGlu, pg8::StaticOrder, true, true>(lds, g, S, E, wid_s); }
        GRID_SYNC();
        { KArgs ka = kargs(); const int G = gridDim.x, cu = blockIdx.x;
          pg8::Gemm g{WSP(bf16, WS_H), WL(WO_DN2), T, DM, FF, FF, FF}; pg8::StaticOrder S; S.init(T, DM, G, cu); EpiResid E{l == 1 ? 1 : 0, 0.5f, l == 0 ? 3 : -1};
          pg8::gemm_phase<EpiResid, pg8::StaticOrder, true, true>(lds, g, S, E, wid_s); }
        if (l == 0) GRID_SYNC();
    }
}

extern "C" void kernel_launch(void* const* d_in, const int* in_sizes, int n_in, void* d_out, int out_size, void* d_ws, size_t ws_size, hipStream_t stream) {
    static int grid = 0;
    if (grid == 0) {
        if (n_in != 30 || out_size != T * DM || ws_size < WS_END) { fprintf(stderr, "kernel_launch: unexpected shapes (n_in %d, out %d, ws %zu)\n", n_in, out_size, ws_size); grid = -1; return; }
        int dev = 0, cus = 0, per_cu = 0;
        hipGetDevice(&dev); hipDeviceGetAttribute(&cus, hipDeviceAttributeMultiprocessorCount, dev);
        hipFuncSetAttribute((const void*)fwd_megakernel, hipFuncAttributeMaxDynamicSharedMemorySize, LDS_BYTES);
        hipOccupancyMaxActiveBlocksPerMultiprocessor(&per_cu, (const void*)fwd_megakernel, NWAVES * 64, LDS_BYTES);
        if (per_cu < 1) { fprintf(stderr, "kernel_launch: occupancy query says %d blocks per CU\n", per_cu); per_cu = 1; }
        (void)hipGetLastError();
        grid = cus * 1;
    }
    if (grid < 0) return;
    (void)hipMemsetAsync(d_ws, 0, 65536, stream);
    Args a{};
    for (int i = 0; i < 30; ++i) a.in[i] = (const float*)d_in[i];
    a.out = (float*)d_out; a.ws = (unsigned char*)d_ws;
    void* kargs[] = {&a};
    hipError_t e = hipLaunchCooperativeKernel((const void*)fwd_megakernel, dim3(grid), dim3(NWAVES * 64), kargs, LDS_BYTES, stream);
    if (e != hipSuccess) fprintf(stderr, "cooperative launch failed: %s (grid %d)\n", hipGetErrorString(e), grid);
}
```

```cpp
#include <hip/hip_runtime.h>
#include <hip/hip_cooperative_groups.h>
#include <cstdio>
#include <cstdint>
namespace cg = cooperative_groups;
namespace pg8 {
#define PG8_LAS __attribute__((address_space(3)))
typedef unsigned short bf16_t;
typedef short bf16x8 __attribute__((ext_vector_type(8)));
typedef float f32x4 __attribute__((ext_vector_type(4)));
typedef unsigned u32x4 __attribute__((ext_vector_type(4)));
constexpr int BM = 256, BK = 64, HALF = 128, HTB = HALF * BK * 2  , STAGE_BYTES = 8 * HTB, NXCD = 8, WGM = 4;

__host__ __device__ __forceinline__ int lds_byte(int r, int c) { const int st = (r >> 4) * 2 + (c >> 5), rr = r & 15, cc = c & 31, ob = rr * 64 + cc * 2; return st * 1024 + (ob ^ (((ob >> 9) & 1) << 5)); }
__host__ __device__ __forceinline__ void stage_rc(int b, int& R, int& C) { const int st = b / 1024, sb = b % 1024, swz = sb ^ (((sb >> 9) & 1) << 5); R = (st >> 1) * 16 + swz / 64; C = (st & 1) * 32 + (swz % 64) / 2; }
__host__ __device__ __forceinline__ int perm32(int rho) { const int n = rho >> 4, i = rho & 15; return 8 * (i >> 2) + 4 * n + (i & 3); }

struct Unit { int pm, pn; int koff = 0, nt = 0, seg = 0; };
struct Gemm { const bf16_t* A; const bf16_t* Bt; int M, N, K, lda, ldb; };

struct StaticOrder {
    int nM, nN, nwg, G, c;
    __host__ __device__ void init(int M, int N, int G_, int c_) { nM = M / BM; nN = N / BM; nwg = nM * nN; G = G_; c = c_; }
    __host__ __device__ bool next(int i, Unit& u) const {
        const long L = (long)i * G + c; if (L >= nwg) return false;
        int wgid = (int)L; { const int q = nwg / NXCD, r = nwg % NXCD, xcd = wgid % NXCD, off = wgid / NXCD; wgid = (xcd < r ? xcd * (q + 1) : r * (q + 1) + (xcd - r) * q) + off; }
        const int nig = WGM * nN, gid = wgid / nig, fm = gid * WGM, gsz = (nM - fm) < WGM ? (nM - fm) : WGM;
        u.pm = fm + ((wgid % nig) % gsz); u.pn = (wgid % nig) / gsz; return true;
    }
    __device__ __forceinline__ void a_ready(const Unit&) const {}
    __device__ __forceinline__ void done(const Unit&) const {}
};

__device__ __forceinline__ unsigned cvt_pk_bf16(float lo, float hi) { unsigned r; asm volatile("v_cvt_pk_bf16_f32 %0, %1, %2" : "=v"(r) : "v"(lo), "v"(hi)); return r; }
typedef float f32x2 __attribute__((ext_vector_type(2)));
__device__ __forceinline__ f32x2 gelu_pk(f32x2 v) {
    const f32x2 av = __builtin_elementwise_abs(v), d = av * 0.2316418882f + 1.0f;
    f32x2 t; t.x = __builtin_amdgcn_rcpf(d.x); t.y = __builtin_amdgcn_rcpf(d.y);
    f32x2 q = t * 0.5307027145f + (-0.7265760135f); q = q * t + 0.7107068705f; q = q * t + (-0.142248368f); q = q * t + 0.127414796f; q = q * t;
    const f32x2 s = (v * v) * (-0.72134752044f);
    f32x2 e; e.x = __builtin_amdgcn_exp2f(s.x); e.y = __builtin_amdgcn_exp2f(s.y);
    const f32x2 m = v * (q * e), r = v - m;
    f32x2 o; o.x = v.x < 0.f ? m.x : r.x; o.y = v.y < 0.f ? m.y : r.y; return o;
}

template <int ACT  > struct EpiBf16 {
    static constexpr bool PERM = true, AFTER_DRAIN = false; static_assert(ACT == 0 || ACT == 1, "EpiBf16: ACT is 0 (none) or 1 (gelu_pk)");
    bf16_t* O; int ldc; const float* bias; int split_cols; size_t split_stride; float scale0;
    __device__ __forceinline__ void operator()(const f32x4 (&acc)[2][2][4][2], const Unit& u, int wr, int wc, int fr, int fq) const {
        const int row0 = u.pm * BM + wr * 64 + fr; int colt = u.pn * BM; bf16_t* base = O;
        float sc = 1.f; if (split_cols) { const int t = colt / split_cols; base += (size_t)t * split_stride; colt -= t * split_cols; if (t == 0) sc = scale0; }
        const int col0 = colt + wc * 32 + 8 * fq, bcol0 = u.pn * BM + wc * 32 + 8 * fq;
        f32x4 bv[2][2];
#pragma unroll
        for (int bj = 0; bj < 2; ++bj)
#pragma unroll
            for (int n = 0; n < 2; ++n) bv[bj][n] = bias ? *(const f32x4*)(bias + bcol0 + bj * HALF + 4 * n) : (f32x4){0.f, 0.f, 0.f, 0.f};
#pragma unroll
        for (int ai = 0; ai < 2; ++ai)
#pragma unroll
            for (int m = 0; m < 4; ++m) { bf16_t* rowp = base + (size_t)(row0 + ai * HALF + m * 16) * ldc + col0;
#pragma unroll
                for (int bj = 0; bj < 2; ++bj) { f32x4 v0 = acc[ai][bj][m][0] + bv[bj][0], v1 = acc[ai][bj][m][1] + bv[bj][1];
                    if (ACT == 1) { f32x2 a = gelu_pk((f32x2){v0[0], v0[1]}), b = gelu_pk((f32x2){v0[2], v0[3]}), c = gelu_pk((f32x2){v1[0], v1[1]}), d = gelu_pk((f32x2){v1[2], v1[3]});
                        v0 = (f32x4){a.x, a.y, b.x, b.y}; v1 = (f32x4){c.x, c.y, d.x, d.y}; }
                    v0 = v0 * sc; v1 = v1 * sc; u32x4 w; w.x = cvt_pk_bf16(v0[0], v0[1]); w.y = cvt_pk_bf16(v0[2], v0[3]); w.z = cvt_pk_bf16(v1[0], v1[1]); w.w = cvt_pk_bf16(v1[2], v1[3]);
                    *(u32x4*)(rowp + bj * HALF) = w; } }
    }
};

template <class Epi, class Sched, bool ALIGN_EPI = false, bool SP2 = false>
__device__ __forceinline__ void gemm_phase(PG8_LAS unsigned char* lds, const Gemm g, const Sched& S, const Epi& E, int wid_s) {
    unsigned z_ = 0u; asm volatile("" : "+v"(z_)); const int tid = wid_s * 64 + (int)__builtin_amdgcn_mbcnt_hi(~0u, __builtin_amdgcn_mbcnt_lo(~0u, z_));
    const int wid = __builtin_amdgcn_readfirstlane(tid >> 6), lane = tid & 63, wr = wid >> 2, wc = wid & 3, fr = lane & 15, fq = lane >> 4;
    int K = g.K; asm volatile("" : "+s"(K));
    const int nt = K / BK;
    unsigned voffA[2], voffB[2];
#pragma unroll
    for (int i = 0; i < 2; ++i) { int R, C; stage_rc(tid * 16 + i * 8192, R, C); const int Rb = Epi::PERM ? ((R & ~31) + perm32(R & 31)) : R;
        voffA[i] = (unsigned)(R * g.lda + C) * 2u; voffB[i] = (unsigned)(Rb * g.ldb + C) * 2u; }
    const size_t kstep = (size_t)(BK * 2);
    const size_t hstepA = (size_t)HALF * g.lda * 2, hstepB = (size_t)HALF * g.ldb * 2;
    const size_t tstepA = 2 * hstepA, tstepB = 2 * hstepB;
    const unsigned ldsw = (unsigned)wid * 1024u;
    const int aoff = lds_byte(wr * 64 + fr, fq * 8), boff = lds_byte(wc * 32 + fr, fq * 8);
#define PG8_SA(b, h) (((b) * 2 + (h)) * HTB)
#define PG8_SB(b, h) ((4 + (b) * 2 + (h)) * HTB)
#define PG8_STAGE(bufoff, gbase, voff) do { _Pragma("unroll") for (int _i = 0; _i < 2; ++_i) \
        __builtin_amdgcn_global_load_lds((const unsigned*)((const char*)(gbase) + (voff)[_i]), (PG8_LAS unsigned*)(lds + (bufoff) + ldsw + _i * 8192), 16, 0, 0); } while (0)
#define PG8_LDA(dst, b, h) do { _Pragma("unroll") for (int m = 0; m < 4; ++m) _Pragma("unroll") for (int k = 0; k < 2; ++k) dst[m][k] = *(const PG8_LAS bf16x8*)(lds + PG8_SA(b, h) + aoff + m * 2048 + k * 1024); } while (0)
#define PG8_LDB(dst, b, h) do { _Pragma("unroll") for (int n = 0; n < 2; ++n) _Pragma("unroll") for (int k = 0; k < 2; ++k) dst[n][k] = *(const PG8_LAS bf16x8*)(lds + PG8_SB(b, h) + boff + n * 2048 + k * 1024); } while (0)
#define PG8_MMA(ai, bj, At, Bt) do { __builtin_amdgcn_s_setprio(1); _Pragma("unroll") for (int m = 0; m < 4; ++m) _Pragma("unroll") for (int n = 0; n < 2; ++n) _Pragma("unroll") for (int k = 0; k < 2; ++k) \
        acc[ai][bj][m][n] = __builtin_amdgcn_mfma_f32_16x16x32_bf16(Bt[n][k], At[m][k], acc[ai][bj][m][n], 0, 0, 0); __builtin_amdgcn_s_setprio(0); } while (0)
#define PG8_WAIT_V(n) asm volatile("s_waitcnt vmcnt(" #n ")" ::: "memory")
#define PG8_WAIT_L(n) asm volatile("s_waitcnt lgkmcnt(" #n ")" ::: "memory")
#define PG8_BAR __builtin_amdgcn_s_barrier()
#define PG8_SCHED __builtin_amdgcn_sched_barrier(0)
    Unit cur, nxt; int ui = 0;
    if (!S.next(0, cur)) return;
    f32x4 acc[2][2][4][2];
#pragma unroll
    for (int a = 0; a < 2; ++a)
#pragma unroll
        for (int b = 0; b < 2; ++b)
#pragma unroll
            for (int m = 0; m < 4; ++m)
#pragma unroll
                for (int n = 0; n < 2; ++n) acc[a][b][m][n] = (f32x4){0.f, 0.f, 0.f, 0.f};
    bf16x8 At[4][2], B0[2][2], B1[2][2];
    const char* cA = (const char*)g.A + (size_t)cur.pm * tstepA + (size_t)cur.koff * 2; const char* cB = (const char*)g.Bt + (size_t)cur.pn * tstepB + (size_t)cur.koff * 2;
    S.a_ready(cur);
    if constexpr (SP2) {
        PG8_STAGE(PG8_SB(0, 0), cB, voffB); PG8_STAGE(PG8_SB(0, 1), cB + hstepB, voffB); PG8_STAGE(PG8_SA(0, 0), cA, voffA); PG8_STAGE(PG8_SA(0, 1), cA + hstepA, voffA);
        if (wr == 1) PG8_BAR;
        PG8_WAIT_V(2); PG8_BAR;
        PG8_STAGE(PG8_SB(1, 0), cB + kstep, voffB); PG8_STAGE(PG8_SA(1, 0), cA + kstep, voffA); PG8_STAGE(PG8_SB(1, 1), cB + hstepB + kstep, voffB);
        PG8_WAIT_V(6); PG8_BAR;
    } else {
        PG8_STAGE(PG8_SB(0, 0), cB, voffB); PG8_STAGE(PG8_SA(0, 0), cA, voffA); PG8_STAGE(PG8_SB(0, 1), cB + hstepB, voffB); PG8_STAGE(PG8_SA(0, 1), cA + hstepA, voffA);
        if (wr == 1) PG8_BAR;
        PG8_WAIT_V(4); PG8_BAR;
        PG8_STAGE(PG8_SB(1, 0), cB + kstep, voffB); PG8_STAGE(PG8_SA(1, 0), cA + kstep, voffA); PG8_STAGE(PG8_SB(1, 1), cB + hstepB + kstep, voffB);
        PG8_WAIT_V(6); PG8_BAR;
    }
    for (;;) {
        const bool has_next = S.next(ui + 1, nxt);
        const char* nA = has_next ? (const char*)g.A + (size_t)nxt.pm * tstepA + (size_t)nxt.koff * 2 : cA; const char* nB = has_next ? (const char*)g.Bt + (size_t)nxt.pn * tstepB + (size_t)nxt.koff * 2 : cB;
        const int ntc = cur.nt ? cur.nt : nt;
        for (int t = 0; t < ntc; t += 2) {
            const bool last = (t == ntc - 2);
            const char* a1 = cA + (size_t)(t + 1) * kstep;
            const char* a2 = last ? nA : cA + (size_t)(t + 2) * kstep; const char* b2 = last ? nB : cB + (size_t)(t + 2) * kstep;
            const char* a3 = a2 + kstep; const char* b3 = b2 + kstep;
            if (last && has_next) S.a_ready(nxt);
            if constexpr (SP2) {
            PG8_LDB(B0, 0, 0); PG8_LDB(B1, 0, 1); PG8_SCHED; PG8_LDA(At, 0, 0); PG8_STAGE(PG8_SA(1, 1), a1 + hstepA, voffA);
            PG8_WAIT_V(8); PG8_WAIT_L(0); PG8_BAR; PG8_MMA(0, 0, At, B0); PG8_MMA(0, 1, At, B1); PG8_BAR; PG8_SCHED;
            PG8_LDA(At, 0, 1); PG8_STAGE(PG8_SB(0, 0), b2, voffB); PG8_STAGE(PG8_SB(0, 1), b2 + hstepB, voffB); PG8_STAGE(PG8_SA(0, 0), a2, voffA);
            PG8_WAIT_V(8); PG8_WAIT_L(0); PG8_BAR; PG8_MMA(1, 0, At, B0); PG8_MMA(1, 1, At, B1); PG8_BAR; PG8_SCHED;
            PG8_LDB(B0, 1, 0); PG8_LDB(B1, 1, 1); PG8_SCHED; PG8_LDA(At, 1, 0); PG8_STAGE(PG8_SA(0, 1), a2 + hstepA, voffA);
            PG8_WAIT_V(8); PG8_WAIT_L(0); PG8_BAR; PG8_MMA(0, 0, At, B0); PG8_MMA(0, 1, At, B1); PG8_BAR; PG8_SCHED;
            PG8_LDA(At, 1, 1); PG8_STAGE(PG8_SB(1, 0), b3, voffB); PG8_STAGE(PG8_SB(1, 1), b3 + hstepB, voffB); PG8_STAGE(PG8_SA(1, 0), a3, voffA);
            PG8_WAIT_V(8); PG8_WAIT_L(0); PG8_BAR; PG8_MMA(1, 0, At, B0); PG8_MMA(1, 1, At, B1); PG8_BAR; PG8_SCHED;
            } else {
            PG8_LDB(B0, 0, 0); PG8_SCHED; PG8_LDA(At, 0, 0); PG8_STAGE(PG8_SA(1, 1), a1 + hstepA, voffA);
            PG8_WAIT_L(8); PG8_BAR; PG8_WAIT_L(0); PG8_MMA(0, 0, At, B0); PG8_BAR; PG8_SCHED;
            PG8_LDB(B1, 0, 1); PG8_STAGE(PG8_SB(0, 0), b2, voffB);
            PG8_BAR; PG8_WAIT_L(0); PG8_MMA(0, 1, At, B1); PG8_BAR;
            PG8_LDA(At, 0, 1); PG8_STAGE(PG8_SA(0, 0), a2, voffA);
            PG8_BAR; PG8_WAIT_L(0); PG8_MMA(1, 0, At, B0); PG8_BAR; PG8_SCHED;
            PG8_STAGE(PG8_SB(0, 1), b2 + hstepB, voffB);
            PG8_WAIT_V(6); PG8_BAR; PG8_MMA(1, 1, At, B1); PG8_BAR;
            PG8_LDB(B0, 1, 0); PG8_SCHED; PG8_LDA(At, 1, 0); PG8_STAGE(PG8_SA(0, 1), a2 + hstepA, voffA);
            PG8_WAIT_L(8); PG8_BAR; PG8_WAIT_L(0); PG8_MMA(0, 0, At, B0); PG8_BAR; PG8_SCHED;
            PG8_LDB(B1, 1, 1); PG8_STAGE(PG8_SB(1, 0), b3, voffB);
            PG8_BAR; PG8_WAIT_L(0); PG8_MMA(0, 1, At, B1); PG8_BAR;
            PG8_LDA(At, 1, 1); PG8_STAGE(PG8_SA(1, 0), a3, voffA);
            PG8_BAR; PG8_WAIT_L(0); PG8_MMA(1, 0, At, B0); PG8_BAR; PG8_SCHED;
            PG8_STAGE(PG8_SB(1, 1), b3 + hstepB, voffB);
            PG8_WAIT_V(6); PG8_BAR; PG8_MMA(1, 1, At, B1); PG8_BAR;
            }
        }
        if constexpr (ALIGN_EPI) { if (wr == 0) PG8_BAR; }
        if constexpr (!Epi::AFTER_DRAIN) { E(acc, cur, wr, wc, fr, fq); S.done(cur); }
        if (!has_next) break;
#pragma unroll
        for (int a = 0; a < 2; ++a)
#pragma unroll
            for (int b = 0; b < 2; ++b)
#pragma unroll
                for (int m = 0; m < 4; ++m)
#pragma unroll
                    for (int n = 0; n < 2; ++n) acc[a][b][m][n] = (f32x4){0.f, 0.f, 0.f, 0.f};
        cur = nxt; cA = nA; cB = nB; ++ui;
        if constexpr (ALIGN_EPI) { if (wr == 1) PG8_BAR; }
    }
    PG8_WAIT_V(0);
    if constexpr (!ALIGN_EPI) { if (wr == 0) PG8_BAR; }
    PG8_BAR;
    if constexpr (Epi::AFTER_DRAIN) { E.fused(acc, cur, wr, wc, fr, fq, lds, wid, lane); S.done(cur); }
#undef PG8_SA
#undef PG8_SB
#undef PG8_STAGE
#undef PG8_LDA
#undef PG8_LDB
#undef PG8_MMA
#undef PG8_WAIT_V
#undef PG8_WAIT_L
#undef PG8_BAR
#undef PG8_SCHED
}
}
constexpr int NWAVES = 8;
constexpr int T = 65536, DM = 1024, FF = 2816, NUP = 2 * FF, INC = 5376, SEQ = 4096, NB = 16;
constexpr float EPS = 1e-6f;
constexpr size_t MiB = 1u << 20;
constexpr size_t WS_APOW = 1 * MiB;
constexpr size_t WS_BBAR = 2 * MiB + 512 * 1024;
constexpr size_t WS_KMAT = 3 * MiB;
constexpr size_t WS_W = 5 * MiB, W_LSTRIDE = 93 * MiB;
constexpr size_t WO_UP1 = 0, WO_DN1 = 11 * MiB, WO_IN = 16 * MiB + 512 * 1024, WO_GLU = 27 * MiB, WO_BR = 27 * MiB + 256 * 1024, WO_OUT = 29 * MiB + 256 * 1024,
                 WO_UP2 = 31 * MiB + 256 * 1024, WO_DN2 = 42 * MiB + 256 * 1024, WO_BS5 = 47 * MiB + 768 * 1024;
constexpr size_t WS_XN = 192 * MiB;
constexpr size_t WS_H = 320 * MiB;
constexpr size_t WS_G = 320 * MiB;
constexpr size_t WS_Q = 704 * MiB, WS_K = 768 * MiB, WS_V = 832 * MiB;
constexpr size_t WS_MG = 704 * MiB;
constexpr size_t WS_AS5 = 896 * MiB;
constexpr size_t WS_ZG = 932 * MiB;
constexpr size_t WS_END = 968 * MiB;
typedef unsigned long long rss_t;
constexpr float RSS_FIX = 16777216.0f, RSS_INV = 1.0f / 16777216.0f;
constexpr size_t WS_RSS = 964 * MiB;
constexpr int LDS_BYTES = 147456;
constexpr int AS5_LD = 1152, BS5_ROWS = 1280;

#define GAS __attribute__((address_space(1)))
#define LAS __attribute__((address_space(3)))
typedef unsigned short bf16;
typedef unsigned v4u __attribute__((ext_vector_type(4)));
typedef unsigned v2u __attribute__((ext_vector_type(2)));
typedef float f32x4 __attribute__((ext_vector_type(4)));
typedef float f32x2 __attribute__((ext_vector_type(2)));
typedef short bf16x8 __attribute__((ext_vector_type(8)));
typedef short s16x4 __attribute__((ext_vector_type(4)));
__device__ __forceinline__ unsigned f2bf(float f) { unsigned u = __builtin_bit_cast(unsigned, f); return (u + 0x7fffu + ((u >> 16) & 1u)) >> 16; }
__device__ __forceinline__ unsigned pk2(float lo, float hi) { return f2bf(lo) | (f2bf(hi) << 16); }
__device__ __forceinline__ float bflo(unsigned w) { return __builtin_bit_cast(float, w << 16); }
__device__ __forceinline__ float bfhi(unsigned w) { return __builtin_bit_cast(float, w & 0xffff0000u); }
__device__ __forceinline__ float fsigmoid(float x) { return __builtin_amdgcn_rcpf(1.0f + __expf(-x)); }
__device__ __forceinline__ float shx(float v, int m, int lane) { return __builtin_bit_cast(float, __builtin_amdgcn_ds_bpermute((lane ^ m) << 2, __builtin_bit_cast(int, v))); }
__device__ __forceinline__ float wave_sum(float v, int lane) {
#pragma unroll
    for (int o = 1; o < 64; o <<= 1) v += shx(v, o, lane);
    return v;
}


#define XB_TMO      128
#define XB_XCNT(j)  (256  + 64 * (j))
#define XB_XSUB(j)  (1280 + 64 * (j))
#define XB_XGEN(j)  (2304 + 64 * (j))
#define XB_TOP      3328
#define XB_TOPGEN   3392
#define XCD_BAR_WORDS 3456
#define XB_SPIN_CAP (1u << 18)

__device__ __forceinline__ unsigned xb_ld(unsigned* p)              { return __hip_atomic_load(p, __ATOMIC_RELAXED, __HIP_MEMORY_SCOPE_AGENT); }
__device__ __forceinline__ unsigned xb_add(unsigned* p, unsigned v) { return __hip_atomic_fetch_add(p, v, __ATOMIC_RELAXED, __HIP_MEMORY_SCOPE_AGENT); }
__device__ __forceinline__ unsigned xb_xcc_id() { return (unsigned)__builtin_amdgcn_s_getreg((3 << 11) | 20) & 0xFu; }
#define XB_SPIN(cond, bar) do { unsigned _sp = 0; while (cond) { __builtin_amdgcn_s_sleep(1); \
    if ((++_sp & 255u) == 0u) { if (xb_ld(&(bar)[XB_TMO])) break; if (_sp > XB_SPIN_CAP) { atomicAdd(&(bar)[XB_TMO], 1u); break; } } } } while (0)

struct XcdBarrier {
    unsigned* bar; unsigned x;
    volatile LAS unsigned* st;
};

__device__ __forceinline__ XcdBarrier xcd_barrier_post(unsigned* bar, volatile LAS unsigned* st, bool leader) {
    XcdBarrier b; b.bar = bar; b.x = xb_xcc_id(); b.st = st;
    if (leader) (void)xb_add(&bar[XB_XCNT(b.x)], 1u);
    return b;
}
__device__ __forceinline__ void xcd_barrier_complete(unsigned* bar, unsigned x, unsigned& nloc, unsigned& nx) {
    const unsigned G = gridDim.x * gridDim.y * gridDim.z;
    unsigned sum, cnt, mine, sp = 0u;
    for (;;) {
        sum = 0u; cnt = 0u; mine = 0u;
#pragma unroll
        for (unsigned j = 0; j < 16; ++j) { const unsigned c = xb_ld(&bar[XB_XCNT(j)]); sum += c; cnt += (c > 0u) ? 1u : 0u; mine = (j == x) ? c : mine; }
        if (sum == G) break;
        __builtin_amdgcn_s_sleep(1);
        if ((++sp & 255u) == 0u) { if (xb_ld(&bar[XB_TMO])) break; if (sp > XB_SPIN_CAP) { atomicAdd(&bar[XB_TMO], 1u); break; } }
    }
    nloc = mine > 0u ? mine : 1u; nx = cnt > 0u ? cnt : 1u;
}

__device__ __forceinline__ void xcd_barrier(const XcdBarrier& b, bool leader) {
    asm volatile("s_waitcnt vmcnt(0)" ::: "memory");
    __syncthreads();
    if (leader) {
        unsigned* bar = b.bar;
        __builtin_amdgcn_s_waitcnt(0);
        unsigned nloc = b.st[0], nx = b.st[1];
        if (nloc == 0u) { xcd_barrier_complete(bar, b.x, nloc, nx); b.st[0] = nloc; b.st[1] = nx; }
        const unsigned old = xb_add(&bar[XB_XSUB(b.x)], 1u);
        const unsigned gen = old / nloc;
        if (old + 1u == (gen + 1u) * nloc) {
            __builtin_amdgcn_fence(__ATOMIC_RELEASE, "agent");
            asm volatile("s_waitcnt vmcnt(0)" ::: "memory");
            const unsigned og = xb_add(&bar[XB_TOP], 1u);
            const unsigned tg = og / nx;
            if (og + 1u == (tg + 1u) * nx) xb_add(&bar[XB_TOPGEN], 1u);
            else XB_SPIN(xb_ld(&bar[XB_TOPGEN]) == tg, bar);
            __builtin_amdgcn_fence(__ATOMIC_ACQUIRE, "agent");
            xb_add(&bar[XB_XGEN(b.x)], 1u);
            asm volatile("s_waitcnt vmcnt(0)" ::: "memory");
        } else {
            XB_SPIN(xb_ld(&bar[XB_XGEN(b.x)]) == gen, bar);
            __builtin_amdgcn_fence(__ATOMIC_ACQUIRE, "agent");
            asm volatile("s_waitcnt vmcnt(0)" ::: "memory");
        }
    }
    __syncthreads();
}

struct Args { const float* in[30]; float* out; unsigned char* ws; };
typedef const Args __attribute__((address_space(4)))* KArgs;
__device__ __forceinline__ KArgs kargs() { auto p = __builtin_amdgcn_kernarg_segment_ptr(); asm volatile("" : "+s"(p)); return (KArgs)p; }
using pg8::Unit; using pg8::cvt_pk_bf16;
template <int ACT> struct EpiGlu {
    static constexpr bool PERM = true, AFTER_DRAIN = false;
    bf16* O; int ldc; int col_off; int rssi;
    __device__ __forceinline__ void operator()(const f32x4 (&acc)[2][2][4][2], const Unit& u, int wr, int wc, int fr, int fq) const {
        const rss_t* rss = rssi >= 0 ? (const rss_t*)(kargs()->ws + WS_RSS) + (size_t)rssi * T : nullptr;
        const int row0 = u.pm * 256 + wr * 64 + fr; const int col0 = col_off + u.pn * 128 + wc * 16 + 4 * fq;
#pragma unroll
        for (int ai = 0; ai < 2; ++ai)
#pragma unroll
            for (int m = 0; m < 4; ++m) { const int row = row0 + ai * 128 + m * 16; bf16* rowp = O + (size_t)row * ldc + col0;
                const float rs = rss ? __builtin_amdgcn_rsqf((float)rss[row] * (RSS_INV / DM) + EPS) : 1.f;
#pragma unroll
                for (int bj = 0; bj < 2; ++bj) { const f32x4 a = acc[ai][bj][m][0] * rs, b = acc[ai][bj][m][1] * rs; f32x4 r;
#pragma unroll
                    for (int i = 0; i < 4; ++i) r[i] = (ACT == 0) ? a[i] * fsigmoid(a[i]) * b[i] : a[i] * fsigmoid(b[i]);
                    v2u w; w.x = cvt_pk_bf16(r[0], r[1]); w.y = cvt_pk_bf16(r[2], r[3]); *(v2u*)(rowp + bj * 64) = w; } }
    }
};
struct EpiSwiGlu {
    static constexpr bool PERM = true, AFTER_DRAIN = false;
    bf16* O; int ldc; int rssi;
    __device__ __forceinline__ void operator()(const f32x4 (&acc)[2][2][4][2], const Unit& u, int wr, int wc, int fr, int fq) const {
        const rss_t* rss = (const rss_t*)(kargs()->ws + WS_RSS) + (size_t)rssi * T;
        const int row0 = u.pm * 256 + wr * 64 + fr; const int col0 = u.pn * 128 + wc * 32 + 8 * fq;
#pragma unroll
        for (int ai = 0; ai < 2; ++ai)
#pragma unroll
            for (int m = 0; m < 4; ++m) { const int row = row0 + ai * 128 + m * 16;
                const float rs = __builtin_amdgcn_rsqf((float)rss[row] * (RSS_INV / DM) + EPS); const float rs2 = rs * rs, rsl = rs * -1.44269504089f;
                float r[8];
#pragma unroll
                for (int n = 0; n < 2; ++n) { const f32x4 a = acc[ai][0][m][n], b = acc[ai][1][m][n];
#pragma unroll
                    for (int i = 0; i < 4; ++i) r[4 * n + i] = (a[i] * b[i]) * rs2 * __builtin_amdgcn_rcpf(1.0f + __builtin_amdgcn_exp2f(a[i] * rsl)); }
                v4u w; w.x = cvt_pk_bf16(r[0], r[1]); w.y = cvt_pk_bf16(r[2], r[3]); w.z = cvt_pk_bf16(r[4], r[5]); w.w = cvt_pk_bf16(r[6], r[7]);
                *(v4u*)(O + (size_t)row * ldc + col0) = w; }
    }
};
struct EpiResid {
    static constexpr bool PERM = true, AFTER_DRAIN = false;
    int final_out; float s; int rssi;
    __device__ __forceinline__ void operator()(const f32x4 (&acc)[2][2][4][2], const Unit& u, int wr, int wc, int fr, int fq) const {
        KArgs ka = kargs(); bf16* xb = (bf16*)(ka->ws + WS_XN); float* xout = ka->out;
        rss_t* rss = (rss_t*)(ka->ws + WS_RSS) + (size_t)(rssi < 0 ? 0 : rssi) * T; const bool emit = rssi >= 0;
        const int row0 = u.pm * 256 + wr * 64 + fr; const int col0 = u.pn * 256 + wc * 32 + 8 * fq; const int lane = fq * 16 + fr;
#pragma unroll
        for (int ai = 0; ai < 2; ++ai)
#pragma unroll
            for (int m = 0; m < 4; ++m) { const int row = row0 + ai * 128 + m * 16; const size_t off = (size_t)row * DM + col0; float ss = 0.f;
#pragma unroll
                for (int bj = 0; bj < 2; ++bj) { const v4u xv = *(const v4u*)(xb + off + bj * 128);
                    const f32x4 y0 = (f32x4){bflo(xv.x), bfhi(xv.x), bflo(xv.y), bfhi(xv.y)} + acc[ai][bj][m][0] * s, y1 = (f32x4){bflo(xv.z), bfhi(xv.z), bflo(xv.w), bfhi(xv.w)} + acc[ai][bj][m][1] * s;
                    ss += ((y0.x * y0.x + y0.y * y0.y) + (y0.z * y0.z + y0.w * y0.w)) + ((y1.x * y1.x + y1.y * y1.y) + (y1.z * y1.z + y1.w * y1.w));
                    if (final_out) { *(f32x4*)(xout + off + bj * 128) = y0; *(f32x4*)(xout + off + bj * 128 + 4) = y1; }
                    else { v4u w; w.x = cvt_pk_bf16(y0.x, y0.y); w.y = cvt_pk_bf16(y0.z, y0.w); w.z = cvt_pk_bf16(y1.x, y1.y); w.w = cvt_pk_bf16(y1.z, y1.w); *(v4u*)(xb + off + bj * 128) = w; } }
                if (emit) { ss += shx(ss, 16, lane); ss += shx(ss, 32, lane); if (fq == 0) (void)__hip_atomic_fetch_add(rss + row, (rss_t)(ss * RSS_FIX), __ATOMIC_RELAXED, __HIP_MEMORY_SCOPE_AGENT); } }
    }
};
struct EpiIn {
    static constexpr bool PERM = true, AFTER_DRAIN = false;
    bf16 *AS5, *Q  , *ZG; unsigned char* G8; int rssi; const float* bgate;
    __device__ __forceinline__ void operator()(const f32x4 (&acc)[2][2][4][2], const Unit& u, int wr, int wc, int fr, int fq) const {
        const int row0 = u.pm * 256 + wr * 64 + fr; const int pn = u.pn; const int cl0 = wc * 32 + 8 * fq;
        const rss_t* rss = (const rss_t*)(kargs()->ws + WS_RSS) + (size_t)rssi * T;
        f32x4 bv[2][2];
        { const int ct = (pn >= 9 ? (pn - 9) * 256 : 0) + cl0;
#pragma unroll
          for (int bj = 0; bj < 2; ++bj)
#pragma unroll
            for (int n = 0; n < 2; ++n) bv[bj][n] = *(const f32x4*)(bgate + ct + bj * 128 + 4 * n); }
        float rsv[2][4];
#pragma unroll
        for (int ai = 0; ai < 2; ++ai)
#pragma unroll
            for (int m = 0; m < 4; ++m) rsv[ai][m] = __builtin_amdgcn_rsqf((float)rss[row0 + ai * 128 + m * 16] * (RSS_INV / DM) + EPS);
        if (pn == 0) {
#pragma unroll
            for (int ai = 0; ai < 2; ++ai)
#pragma unroll
                for (int m = 0; m < 4; ++m) { const float rs = rsv[ai][m]; const int t = row0 + ai * 128 + m * 16; const int b = t >> 12, c = (t >> 6) & 63, j = t & 63;
#pragma unroll
                    for (int bj = 0; bj < 2; ++bj) { const int col = cl0 + bj * 128; const int g = col >> 4, ci0 = col & 15;
                        const f32x4 v0 = (acc[ai][bj][m][0] * rs), v1 = (acc[ai][bj][m][1] * rs); v4u w; w.x = cvt_pk_bf16(v0[0], v0[1]); w.y = cvt_pk_bf16(v0[2], v0[3]); w.z = cvt_pk_bf16(v1[0], v1[1]); w.w = cvt_pk_bf16(v1[2], v1[3]);
                        *(v4u*)(AS5 + ((size_t)(g * 1024 + b * 64 + c) * AS5_LD + j * 16 + ci0)) = w; } }
        } else if (pn <= 6) {
            bf16* base = Q + (size_t)((pn - 1) >> 1) * ((size_t)T * 512); const int colt = ((pn - 1) & 1) * 256 + cl0;
#pragma unroll
            for (int ai = 0; ai < 2; ++ai)
#pragma unroll
                for (int m = 0; m < 4; ++m) { const float rs = rsv[ai][m]; bf16* rowp = base + (size_t)(row0 + ai * 128 + m * 16) * 512 + colt;
#pragma unroll
                    for (int bj = 0; bj < 2; ++bj) { const f32x4 v0 = (acc[ai][bj][m][0] * rs), v1 = (acc[ai][bj][m][1] * rs); v4u w; w.x = cvt_pk_bf16(v0[0], v0[1]); w.y = cvt_pk_bf16(v0[2], v0[3]); w.z = cvt_pk_bf16(v1[0], v1[1]); w.w = cvt_pk_bf16(v1[2], v1[3]);
                        *(v4u*)(rowp + bj * 128) = w; } }
        } else if (pn <= 8) {
            const int col0 = (pn - 7) * 128 + wc * 16 + 4 * fq;
#pragma unroll
            for (int ai = 0; ai < 2; ++ai)
#pragma unroll
                for (int m = 0; m < 4; ++m) { const float rs = rsv[ai][m]; bf16* rowp = ZG + (size_t)(row0 + ai * 128 + m * 16) * 256 + col0;
#pragma unroll
                    for (int bj = 0; bj < 2; ++bj) { const f32x4 a = (acc[ai][bj][m][0] * rs), b = (acc[ai][bj][m][1] * rs); f32x4 r;
#pragma unroll
                        for (int i = 0; i < 4; ++i) r[i] = a[i] * fsigmoid(b[i]);
                        v2u w; w.x = cvt_pk_bf16(r[0], r[1]); w.y = cvt_pk_bf16(r[2], r[3]); *(v2u*)(rowp + bj * 64) = w; } }
        } else {
            const int colt = (pn - 9) * 256 + cl0;
#pragma unroll
            for (int ai = 0; ai < 2; ++ai)
#pragma unroll
                for (int m = 0; m < 4; ++m) { const float rs = rsv[ai][m]; unsigned char* rowp = G8 + (size_t)(row0 + ai * 128 + m * 16) * 3072 + colt;
#pragma unroll
                    for (int bj = 0; bj < 2; ++bj) { const f32x4 v0 = (acc[ai][bj][m][0] * rs) + bv[bj][0], v1 = (acc[ai][bj][m][1] * rs) + bv[bj][1]; v2u w; w.x = 0u; w.y = 0u;
#pragma unroll
                        for (int i = 0; i < 4; ++i) { w.x = __builtin_amdgcn_cvt_pk_u8_f32(fsigmoid(v0[i]) * 255.0f, i, w.x); w.y = __builtin_amdgcn_cvt_pk_u8_f32(fsigmoid(v1[i]) * 255.0f, i, w.y); }
                        *(v2u*)(rowp + bj * 128) = w; } }
        }
    }
};
template <bool FIRST> struct EpiBranch {
    static constexpr bool PERM = true, AFTER_DRAIN = false;
    const bf16* G; bf16* MG; int br; const float* bgate;
    __device__ __forceinline__ void operator()(const f32x4 (&acc)[2][2][4][2], const Unit& u, int wr, int wc, int fr, int fq) const {
        const int row0 = u.pm * 256 + wr * 64 + fr; const int col0 = u.pn * 256 + wc * 32 + 8 * fq;
        f32x4 bv[2][2];
#pragma unroll
        for (int bj = 0; bj < 2; ++bj)
#pragma unroll
            for (int n = 0; n < 2; ++n) bv[bj][n] = *(const f32x4*)(bgate + br * 1024 + col0 + bj * 128 + 4 * n);
#pragma unroll
        for (int ai = 0; ai < 2; ++ai)
#pragma unroll
            for (int m = 0; m < 4; ++m) { const size_t r = (size_t)(row0 + ai * 128 + m * 16);
#pragma unroll
                for (int bj = 0; bj < 2; ++bj) { const v4u gw = *(const v4u*)(G + r * 3072 + br * 1024 + col0 + bj * 128); bf16* mp = MG + r * DM + col0 + bj * 128;
                    const f32x4 a0 = acc[ai][bj][m][0], a1 = acc[ai][bj][m][1]; const f32x4 b0 = bv[bj][0], b1 = bv[bj][1];
                    float o[8] = {a0[0] * fsigmoid(bflo(gw.x) + b0[0]), a0[1] * fsigmoid(bfhi(gw.x) + b0[1]), a0[2] * fsigmoid(bflo(gw.y) + b0[2]), a0[3] * fsigmoid(bfhi(gw.y) + b0[3]),
                                  a1[0] * fsigmoid(bflo(gw.z) + b1[0]), a1[1] * fsigmoid(bfhi(gw.z) + b1[1]), a1[2] * fsigmoid(bflo(gw.w) + b1[2]), a1[3] * fsigmoid(bfhi(gw.w) + b1[3])};
                    if (!FIRST) { const v4u pw = *(const v4u*)mp; o[0] += bflo(pw.x); o[1] += bfhi(pw.x); o[2] += bflo(pw.y); o[3] += bfhi(pw.y); o[4] += bflo(pw.z); o[5] += bfhi(pw.z); o[6] += bflo(pw.w); o[7] += bfhi(pw.w); }
                    v4u w; w.x = cvt_pk_bf16(o[0], o[1]); w.y = cvt_pk_bf16(o[2], o[3]); w.z = cvt_pk_bf16(o[4], o[5]); w.w = cvt_pk_bf16(o[6], o[7]); *(v4u*)mp = w; } }
    }
};
struct EpiBranchSeg {
    static constexpr bool PERM = true, AFTER_DRAIN = false;
    const unsigned char* G8; bf16* MG;
    __device__ __forceinline__ void operator()(const f32x4 (&acc)[2][2][4][2], const Unit& u, int wr, int wc, int fr, int fq) const {
        const int br = u.seg; const int row0 = u.pm * 256 + wr * 64 + fr; const int col0 = u.pn * 256 + wc * 32 + 8 * fq; const float k255 = 1.0f / 255.0f;
#pragma unroll
        for (int ai = 0; ai < 2; ++ai)
#pragma unroll
            for (int m = 0; m < 4; ++m) { const size_t r = (size_t)(row0 + ai * 128 + m * 16);
#pragma unroll
                for (int bj = 0; bj < 2; ++bj) { const v2u gw = *(const v2u*)(G8 + r * 3072 + br * 1024 + col0 + bj * 128); bf16* mp = MG + r * DM + col0 + bj * 128;
                    const f32x4 a0 = acc[ai][bj][m][0] * k255, a1 = acc[ai][bj][m][1] * k255;
                    float o[8] = {a0[0] * (float)(gw.x & 0xffu), a0[1] * (float)((gw.x >> 8) & 0xffu), a0[2] * (float)((gw.x >> 16) & 0xffu), a0[3] * (float)(gw.x >> 24),
                                  a1[0] * (float)(gw.y & 0xffu), a1[1] * (float)((gw.y >> 8) & 0xffu), a1[2] * (float)((gw.y >> 16) & 0xffu), a1[3] * (float)(gw.y >> 24)};
                    if (br != 0) { const v4u pw = *(const v4u*)mp; o[0] += bflo(pw.x); o[1] += bfhi(pw.x); o[2] += bflo(pw.y); o[3] += bfhi(pw.y); o[4] += bflo(pw.z); o[5] += bfhi(pw.z); o[6] += bflo(pw.w); o[7] += bfhi(pw.w); }
                    v4u w; w.x = cvt_pk_bf16(o[0], o[1]); w.y = cvt_pk_bf16(o[2], o[3]); w.z = cvt_pk_bf16(o[4], o[5]); w.w = cvt_pk_bf16(o[6], o[7]); *(v4u*)mp = w; } }
    }
};
struct BranchOrder { pg8::StaticOrder base;
    __device__ __forceinline__ bool next(int i, Unit& u) const { const int ti = i / 3, br = i - 3 * ti; if (!base.next(ti, u)) return false; u.seg = br; u.koff = br == 0 ? 0 : (br == 1 ? 256 : 768); u.nt = br == 1 ? 8 : 4; return true; }
    __device__ __forceinline__ void a_ready(const Unit&) const {} __device__ __forceinline__ void done(const Unit&) const {} };
struct EpiS5Y {
    static constexpr bool PERM = true, AFTER_DRAIN = false;
    bf16* S5G;
    __device__ __forceinline__ void operator()(const f32x4 (&acc)[2][2][4][2], const Unit& u, int wr, int wc, int fr, int fq) const {
        const int g = u.pm >> 2, rb = u.pm & 3, nb = u.pn - 5 * g;
        const int r0 = rb * 256 + wr * 64 + fr;
#pragma unroll
        for (int ai = 0; ai < 2; ++ai)
#pragma unroll
            for (int m = 0; m < 4; ++m) { const int r = r0 + ai * 128 + m * 16; const int b = r >> 6, c = r & 63;
#pragma unroll
                for (int bj = 0; bj < 2; ++bj) { const int col = nb * 256 + bj * 128 + wc * 32 + 8 * fq; const int i = col >> 4, co0 = col & 15;
                    const f32x4 v0 = acc[ai][bj][m][0], v1 = acc[ai][bj][m][1]; float o[8] = {v0[0], v0[1], v0[2], v0[3], v1[0], v1[1], v1[2], v1[3]};
#pragma unroll
                    for (int q = 0; q < 8; ++q) { const float x = o[q]; o[q] = x * fsigmoid(1.5957691216f * (x + 0.044715f * x * x * x)); }
                    v4u w; w.x = cvt_pk_bf16(o[0], o[1]); w.y = cvt_pk_bf16(o[2], o[3]); w.z = cvt_pk_bf16(o[4], o[5]); w.w = cvt_pk_bf16(o[6], o[7]);
                    *(v4u*)(S5G + ((size_t)(b * SEQ + c * 64 + i) * 256 + g * 16 + co0)) = w; } }
    }
};
struct EpiS5State {
    static constexpr bool PERM = false, AFTER_DRAIN = true;
    bf16* AS5; const f32x2* apow;
    __device__ __forceinline__ void operator()(const f32x4 (&)[2][2][4][2], const Unit&, int, int, int, int) const {}
    __device__ __forceinline__ void fused(f32x4 (&acc)[2][2][4][2], const Unit& u, int wr, int wc, int fr, int fq, PG8_LAS unsigned char* lds, int wid, int lane) const {
        PG8_LAS float* S = (PG8_LAS float*)lds;
        const int g = u.pm >> 2, rb = u.pm & 3;
#pragma unroll
        for (int ai = 0; ai < 2; ++ai)
#pragma unroll
            for (int m = 0; m < 4; ++m)
#pragma unroll
                for (int n = 0; n < 2; ++n) { const int r = ai * 128 + wr * 64 + m * 16 + fr; const int c = wc * 32 + n * 16 + 4 * fq; *(PG8_LAS f32x4*)(S + r * 132 + c) = acc[ai][0][m][n]; }
        asm volatile("s_waitcnt lgkmcnt(0)" ::: "memory"); __builtin_amdgcn_s_barrier(); asm volatile("" ::: "memory");
        const int tid = wid * 64 + lane;
        if (tid < 256) {
            const int bl = tid >> 6, p = tid & 63; const f32x2 a64 = apow[(g * 65 + 64) * 64 + p];
            float xr = 0.f, xi = 0.f; bf16* dst = AS5 + ((size_t)(g * 1024 + rb * 256 + bl * 64) * AS5_LD + 1024 + 2 * p);
            for (int c = 0; c < 64; ++c) { const f32x2 s = *(PG8_LAS f32x2*)(S + (bl * 64 + c) * 132 + 2 * p);
                *(unsigned*)(dst + (size_t)c * AS5_LD) = pk2(xr, xi);
                const float nr = a64.x * xr - a64.y * xi + s.x, ni = a64.x * xi + a64.y * xr + s.y; xr = nr; xi = ni; }
        }
    }
};
struct S5Order1 { int G, c; __device__ bool next(int i, Unit& u) const { const int L = i * G + c; if (L >= 64) return false; const int g = L >> 2, rb = L & 3; u.pm = g * 4 + rb; u.pn = g * 5 + 4; return true; }
    __device__ __forceinline__ void a_ready(const Unit&) const {} __device__ __forceinline__ void done(const Unit&) const {} };
struct S5Order2 { int G, c; __device__ bool next(int i, Unit& u) const { const int L = i * G + c; if (L >= 256) return false; const int g = L >> 4, rb = (L >> 2) & 3, nb = L & 3; u.pm = g * 4 + rb; u.pn = g * 5 + nb; return true; }
    __device__ __forceinline__ void a_ready(const Unit&) const {} __device__ __forceinline__ void done(const Unit&) const {} };

__device__ __forceinline__ void p0_transpose_item(const float* W, int ldw, int srcoff, int mode, int Hh, int Nsub, bf16* WT, int row_off, int ldt, int koff, LAS float* scr, int item, int lane, const float* gain = nullptr) {
    const int nblk = Nsub / 32, kb = item / nblk, nb = item % nblk, k0 = 64 * kb, n0 = 32 * nb;
    const int nn = n0 + (lane & 31); const int sc = srcoff + (mode == 1 ? (((nn & 7) >> 2) * Hh + (nn >> 3) * 4 + (nn & 3)) : mode == 2 ? ((((nn & 255) >> 7) * Hh) + (nn >> 8) * 128 + (nn & 127)) : nn);
    float wv[32];
#pragma unroll
    for (int i = 0; i < 32; ++i) wv[i] = W[(size_t)(k0 + 2 * i + (lane >> 5)) * ldw + sc];
    if (gain) {
#pragma unroll
        for (int i = 0; i < 32; ++i) wv[i] *= gain[k0 + 2 * i + (lane >> 5)]; }
#pragma unroll
    for (int i = 0; i < 32; ++i) scr[(2 * i + (lane >> 5)) * 33 + (lane & 31)] = wv[i];
    asm volatile("s_waitcnt lgkmcnt(0)" ::: "memory");
    const int c = lane & 7;
#pragma unroll
    for (int j = 0; j < 4; ++j) { const int n = (lane >> 3) + 8 * j; const LAS float* s = scr + (8 * c) * 33 + n;
        v4u o; o.x = pk2(s[0 * 33], s[1 * 33]); o.y = pk2(s[2 * 33], s[3 * 33]); o.z = pk2(s[4 * 33], s[5 * 33]); o.w = pk2(s[6 * 33], s[7 * 33]);
        *(v4u*)(WT + (size_t)(row_off + n0 + n) * ldt + koff + k0 + 8 * c) = o; }
    asm volatile("s_waitcnt lgkmcnt(0)" ::: "memory");
}
__device__ __forceinline__ void dsincos(double x, double& s, double& c) {
    const double k = __builtin_rint(x * 0.63661977236758134308);
    double r = __builtin_fma(-k, 1.57079632679489655800, x); r = __builtin_fma(-k, 6.12323399573676603587e-17, r);
    const double r2 = r * r;
    double sp = -1.0 / 1307674368000.0; sp = sp * r2 + 1.0 / 6227020800.0; sp = sp * r2 - 1.0 / 39916800.0; sp = sp * r2 + 1.0 / 362880.0; sp = sp * r2 - 1.0 / 5040.0; sp = sp * r2 + 1.0 / 120.0; sp = sp * r2 - 1.0 / 6.0; sp = sp * r2 + 1.0;
    const double sr = sp * r;
    double cp = 1.0 / 20922789888000.0; cp = cp * r2 - 1.0 / 87178291200.0; cp = cp * r2 + 1.0 / 479001600.0; cp = cp * r2 - 1.0 / 3628800.0; cp = cp * r2 + 1.0 / 40320.0; cp = cp * r2 - 1.0 / 720.0; cp = cp * r2 + 1.0 / 24.0; cp = cp * r2 - 0.5; cp = cp * r2 + 1.0;
    const int q = ((int)k) & 3;
    s = (q == 0) ? sr : (q == 1) ? cp : (q == 2) ? -sr : -cp;
    c = (q == 0) ? cp : (q == 1) ? -sr : (q == 2) ? -cp : sr;
}


__device__ __forceinline__ void rawnorm_phase(const float* x, bf16* XB, rss_t* rss, int wid_s) {
    unsigned z_ = 0u; asm volatile("" : "+v"(z_)); const int tid = wid_s * 64 + (int)__builtin_amdgcn_mbcnt_hi(~0u, __builtin_amdgcn_mbcnt_lo(~0u, z_)); const int wid = __builtin_amdgcn_readfirstlane(tid >> 6), lane = tid & 63;
    const int gw = blockIdx.x * NWAVES + wid, NGW = gridDim.x * NWAVES;
    for (int m = gw; m < T; m += 2 * NGW) {
        const int m1 = m + NGW;
        const f32x4* xr0 = (const f32x4*)(x + (size_t)m * DM) + lane; const f32x4* xr1 = (const f32x4*)(x + (size_t)m1 * DM) + lane; f32x4 v0[4], v1[4]; float s0 = 0.f, s1 = 0.f;
#pragma unroll
        for (int j = 0; j < 4; ++j) { v0[j] = xr0[64 * j]; v1[j] = xr1[64 * j]; }
#pragma unroll
        for (int j = 0; j < 4; ++j) { s0 += (v0[j].x * v0[j].x + v0[j].y * v0[j].y) + (v0[j].z * v0[j].z + v0[j].w * v0[j].w); s1 += (v1[j].x * v1[j].x + v1[j].y * v1[j].y) + (v1[j].z * v1[j].z + v1[j].w * v1[j].w); }
        s0 = wave_sum(s0, lane); s1 = wave_sum(s1, lane); if (lane == 0) { rss[m] = (rss_t)(s0 * RSS_FIX); rss[m1] = (rss_t)(s1 * RSS_FIX); }
        v2u* o0 = (v2u*)(XB + (size_t)m * DM) + lane; v2u* o1 = (v2u*)(XB + (size_t)m1 * DM) + lane;
#pragma unroll
        for (int j = 0; j < 4; ++j) { v2u w; w.x = pk2(v0[j].x, v0[j].y); w.y = pk2(v0[j].z, v0[j].w); o0[64 * j] = w; w.x = pk2(v1[j].x, v1[j].y); w.y = pk2(v1[j].z, v1[j].w); o1[64 * j] = w; }
    }
}

#define DPPF(v, ctrl) __builtin_bit_cast(float, __builtin_amdgcn_update_dpp(0, __builtin_bit_cast(int, (v)), (ctrl), 0xF, 0xF, true))
constexpr int ALD = 72;
__device__ __forceinline__ unsigned cvt_pk_nv(float lo, float hi) { unsigned r; asm("v_cvt_pk_bf16_f32 %0, %1, %2" : "=v"(r) : "v"(lo), "v"(hi)); return r; }
__device__ __forceinline__ void attn_phase(LAS unsigned char* lds, const bf16* Q, const bf16* K, const bf16* V, bf16* OB, const float* qg, const float* kg, const float* relb, int wid_s) {
    unsigned z_ = 0u; asm volatile("" : "+v"(z_)); const int tid = wid_s * 64 + (int)__builtin_amdgcn_mbcnt_hi(~0u, __builtin_amdgcn_mbcnt_lo(~0u, z_)); const int wid = __builtin_amdgcn_readfirstlane(tid >> 6), lane = tid & 63;
    const int fr = lane & 15, fq = lane >> 4;
    LAS bf16* Ks = (LAS bf16*)lds; LAS bf16* Vt = (LAS bf16*)(lds + 2 * 64 * ALD * 2); LAS float* biasS = (LAS float*)(lds + 4 * 64 * ALD * 2);
    const int skey = tid >> 3, spart = tid & 7;
    const int vwcol = skey ^ (spart << 3), vrcol = (fq * 4) ^ ((fr >> 3) << 3);
    float kgv[8];
#pragma unroll
    for (int i = 0; i < 8; ++i) kgv[i] = kg[spart * 8 + i];
    float qgv[2][8];
#pragma unroll
    for (int ks = 0; ks < 2; ++ks)
#pragma unroll
        for (int i = 0; i < 8; ++i) qgv[ks][i] = qg[ks * 32 + fq * 8 + i] * (0.125f * 1.44269504089f);
    v4u krA = (v4u){0u, 0u, 0u, 0u}, vrA = krA, krB = krA, vrB = krA, nq0 = krA, nq1 = krA; float nbias = 0.f; bool pre = false;
    for (int u = blockIdx.x; u < 4096; u += gridDim.x) {
        const int h = u & 7, cp = (u >> 3) & 31, b = u >> 8;
        const int un = u + gridDim.x; const bool has_next = un < 4096; const int hn = un & 7, cpn = (un >> 3) & 31, bn = un >> 8; const int jt0n = (8 - 2 * cpn) > 0 ? (8 - 2 * cpn) : 0;
        const size_t kvbase_n = ((size_t)bn * SEQ + (size_t)(2 * cpn - 8) * 64 + skey) * 512 + hn * 64 + spart * 8;
        const size_t qoff_n = ((size_t)bn * SEQ + (2 * cpn + (wid >> 2)) * 64 + (wid & 3) * 16 + fr) * 512 + hn * 64 + fq * 8;
        const int c = 2 * cp + (wid >> 2); const size_t qrow = (size_t)b * SEQ + c * 64 + (wid & 3) * 16 + fr;
        if (tid < 257) biasS[tid] = (pre ? nbias : relb[h * 257 + tid]) * 1.44269504089f;
        bf16x8 Qb[2];
        { v4u raw[2]; float f[2][8]; float ss = 0.f;
#pragma unroll
            for (int ks = 0; ks < 2; ++ks) { raw[ks] = pre ? (ks ? nq1 : nq0) : *(const v4u*)(Q + qrow * 512 + h * 64 + ks * 32 + fq * 8);
                f[ks][0] = bflo(raw[ks].x); f[ks][1] = bfhi(raw[ks].x); f[ks][2] = bflo(raw[ks].y); f[ks][3] = bfhi(raw[ks].y); f[ks][4] = bflo(raw[ks].z); f[ks][5] = bfhi(raw[ks].z); f[ks][6] = bflo(raw[ks].w); f[ks][7] = bfhi(raw[ks].w);
#pragma unroll
                for (int i = 0; i < 8; ++i) ss += f[ks][i] * f[ks][i]; }
            ss += shx(ss, 16, lane); ss += shx(ss, 32, lane);
            const float rq = 1.0f / sqrtf(ss * (1.f / 64.f) + EPS);
#pragma unroll
            for (int ks = 0; ks < 2; ++ks) { v4u w; w.x = pk2(f[ks][0] * rq * qgv[ks][0], f[ks][1] * rq * qgv[ks][1]); w.y = pk2(f[ks][2] * rq * qgv[ks][2], f[ks][3] * rq * qgv[ks][3]);
                w.z = pk2(f[ks][4] * rq * qgv[ks][4], f[ks][5] * rq * qgv[ks][5]); w.w = pk2(f[ks][6] * rq * qgv[ks][6], f[ks][7] * rq * qgv[ks][7]); Qb[ks] = __builtin_bit_cast(bf16x8, w); } }
        f32x4 o[4];
#pragma unroll
        for (int d = 0; d < 4; ++d) o[d] = (f32x4){0.f, 0.f, 0.f, 0.f};
        float lsum = 0.f;
        const int jt0 = (8 - 2 * cp) > 0 ? (8 - 2 * cp) : 0;
        const size_t kvbase = ((size_t)b * SEQ + (size_t)(2 * cp - 8) * 64 + skey) * 512 + h * 64 + spart * 8;
#define ATT_LOAD(KR, VR, JT) do { KR = *(const v4u*)(K + kvbase + (size_t)(JT) * 64 * 512); VR = *(const v4u*)(V + kvbase + (size_t)(JT) * 64 * 512); } while (0)
#define ATT_STAGE(KR, VR, BUF) do { \
            { float f[8] = {bflo(KR.x), bfhi(KR.x), bflo(KR.y), bfhi(KR.y), bflo(KR.z), bfhi(KR.z), bflo(KR.w), bfhi(KR.w)}; float ss = 0.f; \
                _Pragma("unroll") for (int i = 0; i < 8; ++i) ss += f[i] * f[i]; \
                ss += DPPF(ss, 0xB1); ss += DPPF(ss, 0x4E); ss += DPPF(ss, 0x141);     \
                const float rk = __builtin_amdgcn_rsqf(ss * (1.f / 64.f) + EPS); \
                v4u w; w.x = cvt_pk_nv(f[0] * rk * kgv[0], f[1] * rk * kgv[1]); w.y = cvt_pk_nv(f[2] * rk * kgv[2], f[3] * rk * kgv[3]); w.z = cvt_pk_nv(f[4] * rk * kgv[4], f[5] * rk * kgv[5]); w.w = cvt_pk_nv(f[6] * rk * kgv[6], f[7] * rk * kgv[7]); \
                *(LAS v4u*)(Ks + (BUF) * 64 * ALD + skey * ALD + spart * 8) = w; } \
            { LAS bf16* vp = Vt + (BUF) * 64 * ALD + (spart * 8) * ALD + vwcol; \
                vp[0 * ALD] = (bf16)(VR.x & 0xffffu); vp[1 * ALD] = (bf16)(VR.x >> 16); vp[2 * ALD] = (bf16)(VR.y & 0xffffu); vp[3 * ALD] = (bf16)(VR.y >> 16); \
                vp[4 * ALD] = (bf16)(VR.z & 0xffffu); vp[5 * ALD] = (bf16)(VR.z >> 16); vp[6 * ALD] = (bf16)(VR.w & 0xffffu); vp[7 * ALD] = (bf16)(VR.w >> 16); } } while (0)
#define ATT_BAR() do { asm volatile("s_waitcnt lgkmcnt(0)" ::: "memory"); __builtin_amdgcn_s_barrier(); asm volatile("" ::: "memory"); } while (0)
#define ATT_COMPUTE(JT, BUF) do { const int dt = c - (2 * cp - 8 + (JT)); \
            if (dt >= 0 && dt <= 8) { \
                f32x4 s[4]; \
                _Pragma("unroll") for (int blk = 0; blk < 4; ++blk) { s[blk] = (f32x4){0.f, 0.f, 0.f, 0.f}; \
                    _Pragma("unroll") for (int ks = 0; ks < 2; ++ks) { const bf16x8 a = *(const LAS bf16x8*)(Ks + (BUF) * 64 * ALD + (blk * 16 + fr) * ALD + ks * 32 + fq * 8); s[blk] = __builtin_amdgcn_mfma_f32_16x16x32_bf16(a, Qb[ks], s[blk], 0, 0, 0); } } \
                if (dt >= 3) { const float bc = biasS[256]; \
                    _Pragma("unroll") for (int blk = 0; blk < 4; ++blk) _Pragma("unroll") for (int j = 0; j < 4; ++j) s[blk][j] = __builtin_amdgcn_exp2f(s[blk][j] + bc); \
                } else { const int dbase = dt * 64 + (wid & 3) * 16 + fr - fq * 4; \
                    _Pragma("unroll") for (int blk = 0; blk < 4; ++blk) _Pragma("unroll") for (int j = 0; j < 4; ++j) { int d = dbase - blk * 16 - j; d = d > 128 ? 128 : d; s[blk][j] = __builtin_amdgcn_exp2f(s[blk][j] + biasS[d + 128]); } } \
                bf16x8 Pb[2]; \
                _Pragma("unroll") for (int ks = 0; ks < 2; ++ks) { const f32x4 p0 = s[2 * ks], p1 = s[2 * ks + 1]; lsum += (p0[0] + p0[1]) + (p0[2] + p0[3]) + (p1[0] + p1[1]) + (p1[2] + p1[3]); \
                    v4u w; w.x = cvt_pk_nv(p0[0], p0[1]); w.y = cvt_pk_nv(p0[2], p0[3]); w.z = cvt_pk_nv(p1[0], p1[1]); w.w = cvt_pk_nv(p1[2], p1[3]); Pb[ks] = __builtin_bit_cast(bf16x8, w); } \
                _Pragma("unroll") for (int db = 0; db < 4; ++db) _Pragma("unroll") for (int ks = 0; ks < 2; ++ks) { const LAS bf16* vr = Vt + (BUF) * 64 * ALD + (db * 16 + fr) * ALD + vrcol; \
                        const v2u lo = *(const LAS v2u*)(vr + (((2 * ks) ^ db) << 4)), hi = *(const LAS v2u*)(vr + (((2 * ks + 1) ^ db) << 4));     \
                        v4u w; w.x = lo.x; w.y = lo.y; w.z = hi.x; w.w = hi.y; \
                        o[db] = __builtin_amdgcn_mfma_f32_16x16x32_bf16(__builtin_bit_cast(bf16x8, w), Pb[ks], o[db], 0, 0, 0); } \
            } } while (0)
#define ATT_LOADN(KR, VR, JT) do { KR = *(const v4u*)(K + kvbase_n + (size_t)(JT) * 64 * 512); VR = *(const v4u*)(V + kvbase_n + (size_t)(JT) * 64 * 512); } while (0)
        if (!pre) { ATT_LOAD(krA, vrA, jt0); ATT_LOAD(krB, vrB, jt0 + 1); }
        ATT_STAGE(krA, vrA, 0);
        if (jt0 + 2 < 10) ATT_LOAD(krA, vrA, jt0 + 2); else if (has_next) ATT_LOADN(krA, vrA, jt0n);
        ATT_BAR();
        for (int jt = jt0; jt < 10; jt += 2) {
            ATT_STAGE(krB, vrB, 1);
            if (jt + 3 < 10) ATT_LOAD(krB, vrB, jt + 3);
            else if (has_next) { ATT_LOADN(krB, vrB, jt0n + 1); nq0 = *(const v4u*)(Q + qoff_n); nq1 = *(const v4u*)(Q + qoff_n + 32); if (tid < 257) nbias = relb[hn * 257 + tid]; }
            ATT_COMPUTE(jt, 0);
            ATT_BAR();
            if (jt + 2 < 10) { ATT_STAGE(krA, vrA, 0); if (jt + 4 < 10) ATT_LOAD(krA, vrA, jt + 4); else if (has_next) ATT_LOADN(krA, vrA, jt0n); }
            ATT_COMPUTE(jt + 1, 1);
            ATT_BAR();
        }
#undef ATT_LOAD
#undef ATT_LOADN
#undef ATT_STAGE
#undef ATT_BAR
#undef ATT_COMPUTE
        lsum += shx(lsum, 16, lane); lsum += shx(lsum, 32, lane);
        const float inv = 1.0f / lsum;
        bf16* op = OB + qrow * DM + 256 + h * 64 + fq * 4;
#pragma unroll
        for (int db = 0; db < 4; ++db) { v2u w; w.x = pk2(o[db][0] * inv, o[db][1] * inv); w.y = pk2(o[db][2] * inv, o[db][3] * inv); *(v2u*)(op + db * 16) = w; }
        pre = has_next;
        asm volatile("s_waitcnt lgkmcnt(0)" ::: "memory"); __builtin_amdgcn_s_barrier(); asm volatile("" ::: "memory");
    }
    __syncthreads();
}

__device__ __forceinline__ void conv_phase(LAS unsigned char* lds, const bf16* ZG, bf16* OB, const float* wdw, const float* bdw, const float* lng, const float* lnb, int wid_s) {
    unsigned z_ = 0u; asm volatile("" : "+v"(z_)); const int tid = wid_s * 64 + (int)__builtin_amdgcn_mbcnt_hi(~0u, __builtin_amdgcn_mbcnt_lo(~0u, z_)); const int wid = __builtin_amdgcn_readfirstlane(tid >> 6), lane = tid & 63;
    LAS float* wS = (LAS float*)lds; LAS float* xS = (LAS float*)(lds + 32768);
    for (int i = tid; i < 31 * 256; i += 512) wS[i] = wdw[i];
    const f32x4 bias4 = ((const f32x4*)bdw)[lane], g4 = ((const f32x4*)lng)[lane], b4 = ((const f32x4*)lnb)[lane];
    for (int tile = blockIdx.x; tile < 1024; tile += gridDim.x) {
        const int b = tile >> 6, tin = (tile & 63) * 64;
        __syncthreads();
        for (int i = tid; i < 94 * 32; i += 512) { const int r = i >> 5, pc = i & 31; const int pos = tin - 30 + r; v4u v = (v4u){0u, 0u, 0u, 0u};
            if (pos >= 0) v = *(const v4u*)(ZG + ((size_t)b * SEQ + pos) * 256 + pc * 8);
            LAS f32x4* d = (LAS f32x4*)(xS + r * 256 + pc * 8); d[0] = (f32x4){bflo(v.x), bfhi(v.x), bflo(v.y), bfhi(v.y)}; d[1] = (f32x4){bflo(v.z), bfhi(v.z), bflo(v.w), bfhi(v.w)}; }
        __syncthreads();
        f32x4 acc[8];
#pragma unroll
        for (int j = 0; j < 8; ++j) acc[j] = bias4;
        const LAS float* xb = xS + (wid * 8) * 256 + lane * 4;
        for (int k = 0; k < 31; ++k) { const f32x4 w = *(const LAS f32x4*)(wS + k * 256 + lane * 4);
#pragma unroll
            for (int j = 0; j < 8; ++j) { const f32x4 x = *(const LAS f32x4*)(xb + (j + k) * 256); acc[j] += x * w; } }
#pragma unroll
        for (int j = 0; j < 8; ++j) { const int tok = wid * 8 + j; const f32x4 a4 = acc[j];
            const float mu = wave_sum((a4.x + a4.y) + (a4.z + a4.w), lane) * (1.f / 256.f); const f32x4 d = a4 - mu;
            const float var = wave_sum((d.x * d.x + d.y * d.y) + (d.z * d.z + d.w * d.w), lane) * (1.f / 256.f); const float rstd = 1.0f / sqrtf(var + EPS);
            f32x4 y = d * rstd * g4 + b4; y.x *= fsigmoid(y.x); y.y *= fsigmoid(y.y); y.z *= fsigmoid(y.z); y.w *= fsigmoid(y.w);
            v2u w; w.x = pk2(y.x, y.y); w.y = pk2(y.z, y.w); *(v2u*)(OB + ((size_t)b * SEQ + tin + tok) * DM + 768 + lane * 4) = w; }
    }
    __syncthreads();
}

#define WSP(T_, off) ((T_*)(ka->ws + (off)))
__global__ void __launch_bounds__(NWAVES * 64, 2) fwd_megakernel(Args args_unused) {
    extern __shared__ __attribute__((aligned(16))) unsigned char lds_raw[];
    cg::grid_group grid = cg::this_grid();
    LAS unsigned char* lds = (LAS unsigned char*)lds_raw;
#define GRID_SYNC() do { unsigned z__ = 0u; asm volatile("" : "+v"(z__)); const bool ld__ = (wid_s == 0) && (__builtin_amdgcn_mbcnt_hi(~0u, __builtin_amdgcn_mbcnt_lo(~0u, z__)) == 0u); \
        XcdBarrier xb__ = xbar; asm volatile("" : "+s"(xb__.bar)); xcd_barrier(xb__, ld__);     } while (0)
    const int wid_s = __builtin_amdgcn_readfirstlane((int)threadIdx.x >> 6);
    if (threadIdx.x < 16) ((LAS unsigned*)(lds + LDS_BYTES - 64))[threadIdx.x] = 0u;
    __syncthreads();
    grid.sync();
    XcdBarrier xbar = xcd_barrier_post((unsigned*)(kargs()->ws), (volatile LAS unsigned*)(lds + LDS_BYTES - 64), threadIdx.x == 0);

    {
        KArgs ka = kargs(); unsigned char* ws = ka->ws;
        unsigned z_ = 0u; asm volatile("" : "+v"(z_)); const int tid = wid_s * 64 + (int)__builtin_amdgcn_mbcnt_hi(~0u, __builtin_amdgcn_mbcnt_lo(~0u, z_)); const int wid = __builtin_amdgcn_readfirstlane(tid >> 6), lane = tid & 63;
        const int G = gridDim.x, cu = blockIdx.x; const int gtid = cu * 512 + tid;
        LAS float* scr = (LAS float*)(lds + wid * 16384);
        const int gw = cu * NWAVES + wid, NGW = G * NWAVES;
        constexpr int I_UP = 16 * 176, I_DN = 44 * 32, I_INA = 16 * 56, I_INB = 16 * 16, I_INC = 16 * 96, I_GLU = 4 * 16, I_BS = 4 * 32, I_BA = 8 * 32, I_BC = 4 * 32, I_OUT = 16 * 32;
        constexpr int PER_L = 2 * I_UP + 2 * I_DN + I_INA + I_INB + I_INC + I_GLU + I_BS + I_BA + I_BC + I_OUT;
        for (int it = gw; it < 2 * PER_L; it += NGW) {
            const int l = it >= PER_L ? 1 : 0; int r = it - l * PER_L;
            unsigned char* wl = ws + WS_W + (size_t)l * W_LSTRIDE;
            if (r < I_UP) { p0_transpose_item(ka->in[2] + (size_t)l * DM * NUP, NUP, 0, 2, FF, NUP, (bf16*)(wl + WO_UP1), 0, DM, 0, scr, r, lane, ka->in[1] + l * DM); continue; } r -= I_UP;
            if (r < I_DN) { p0_transpose_item(ka->in[3] + (size_t)l * FF * DM, DM, 0, 0, 0, DM, (bf16*)(wl + WO_DN1), 0, FF, 0, scr, r, lane); continue; } r -= I_DN;
            if (r < I_INA) { p0_transpose_item(ka->in[5] + (size_t)l * DM * INC, INC, 0, 0, 0, 1792, (bf16*)(wl + WO_IN), 0, DM, 0, scr, r, lane, ka->in[4] + l * DM); continue; } r -= I_INA;
            if (r < I_INB) { p0_transpose_item(ka->in[5] + (size_t)l * DM * INC, INC, 1792, 1, 256, 512, (bf16*)(wl + WO_IN), 1792, DM, 0, scr, r, lane, ka->in[4] + l * DM); continue; } r -= I_INB;
            if (r < I_INC) { p0_transpose_item(ka->in[5] + (size_t)l * DM * INC, INC, 2304, 0, 0, 3072, (bf16*)(wl + WO_IN), 2304, DM, 0, scr, r, lane, ka->in[4] + l * DM); continue; } r -= I_INC;
            if (r < I_GLU) { p0_transpose_item(ka->in[15] + (size_t)l * 256 * 512, 512, 0, 1, 256, 512, (bf16*)(wl + WO_GLU), 0, 256, 0, scr, r, lane); continue; } r -= I_GLU;
            if (r < I_BS) { p0_transpose_item(ka->in[16] + (size_t)l * 256 * DM, DM, 0, 0, 0, DM, (bf16*)(wl + WO_BR), 0, DM, 0, scr, r, lane); continue; } r -= I_BS;
            if (r < I_BA) { p0_transpose_item(ka->in[20] + (size_t)l * 512 * DM, DM, 0, 0, 0, DM, (bf16*)(wl + WO_BR), 0, DM, 256, scr, r, lane); continue; } r -= I_BA;
            if (r < I_BC) { p0_transpose_item(ka->in[25] + (size_t)l * 256 * DM, DM, 0, 0, 0, DM, (bf16*)(wl + WO_BR), 0, DM, 768, scr, r, lane); continue; } r -= I_BC;
            if (r < I_OUT) { p0_transpose_item(ka->in[26] + (size_t)l * DM * DM, DM, 0, 0, 0, DM, (bf16*)(wl + WO_OUT), 0, DM, 0, scr, r, lane); continue; } r -= I_OUT;
            if (r < I_UP) { p0_transpose_item(ka->in[28] + (size_t)l * DM * NUP, NUP, 0, 2, FF, NUP, (bf16*)(wl + WO_UP2), 0, DM, 0, scr, r, lane, ka->in[27] + l * DM); continue; } r -= I_UP;
            p0_transpose_item(ka->in[29] + (size_t)l * FF * DM, DM, 0, 0, 0, DM, (bf16*)(wl + WO_DN2), 0, FF, 0, scr, r, lane);
        }
        { rss_t* rz = (rss_t*)(ws + WS_RSS) + T; for (int i = gtid; i < 5 * T; i += G * 512) rz[i] = 0ull; }
        rawnorm_phase(ka->in[0], (bf16*)(ws + WS_XN), (rss_t*)(ws + WS_RSS), wid_s);
        if (gtid < 2048) {
            f32x2* APOW = (f32x2*)(ws + WS_APOW); f32x2* BBAR = (f32x2*)(ws + WS_BBAR);
            const int lg = gtid >> 6, p = gtid & 63;
            const float lre = fminf(ka->in[7][gtid], -1e-4f), lim = ka->in[8][gtid], dt = expf(ka->in[9][lg]);
            const float mag = expf(lre * dt), ang = lim * dt; double sd, cd; dsincos((double)ang, sd, cd);
            const float ar = mag * (float)cd, ai = mag * (float)sd;
            const float den = lre * lre + lim * lim; const float cr = ((ar - 1.0f) * lre + ai * lim) / den, ci = (ai * lre - (ar - 1.0f) * lim) / den;
            for (int c = 0; c < 16; ++c) { const float br = ka->in[10][(size_t)gtid * 16 + c], bi = ka->in[11][(size_t)gtid * 16 + c]; BBAR[(size_t)gtid * 16 + c] = (f32x2){cr * br - ci * bi, cr * bi + ci * br}; }
            double pr = 1.0, pi = 0.0; const double dar = (double)mag * cd, dai = (double)mag * sd;
            for (int lag = 0; lag <= 64; ++lag) { APOW[((size_t)lg * 65 + lag) * 64 + p] = (f32x2){(float)pr, (float)pi}; const double nr = pr * dar - pi * dai, ni = pr * dai + pi * dar; pr = nr; pi = ni; }
        }
    }
    GRID_SYNC();
#define RSS(j) ((float*)(ka->ws + WS_RSS) + (size_t)(j) * T)
#define WL(off) ((const bf16*)(ka->ws + WS_W + (size_t)l * W_LSTRIDE + (off)))
#pragma nounroll
    for (int l = 0; l < 2; ++l) {
        if (l == 0) {
    {
        KArgs ka = kargs(); unsigned char* ws = ka->ws; const f32x2* APOW = (const f32x2*)(ws + WS_APOW); const f32x2* BBAR = (const f32x2*)(ws + WS_BBAR); float* KMAT = (float*)(ws + WS_KMAT);
        unsigned z_ = 0u; asm volatile("" : "+v"(z_)); const int tid = wid_s * 64 + (int)__builtin_amdgcn_mbcnt_hi(~0u, __builtin_amdgcn_mbcnt_lo(~0u, z_)); const int gtid = blockIdx.x * 512 + tid, NT = gridDim.x * 512;
#pragma unroll 2
        for (int it = gtid; it < 2 * 16 * 64 * 256; it += NT) {
            const int ci = it & 15, co = (it >> 4) & 15, lag = (it >> 8) & 63, lg = it >> 14;
            const float* cre = ka->in[12] + ((size_t)lg * 16 + co) * 64; const float* cim = ka->in[13] + ((size_t)lg * 16 + co) * 64;
            const f32x2* ap = APOW + ((size_t)lg * 65 + lag) * 64; const f32x2* bb = BBAR + (size_t)lg * 64 * 16 + ci;
            float s = 0.f;
#pragma unroll 8
            for (int p = 0; p < 64; ++p) { const f32x2 a = ap[p], b = bb[p * 16]; const float wr_ = a.x * b.x - a.y * b.y, wi_ = a.x * b.y + a.y * b.x; s += cre[p] * wr_ - cim[p] * wi_; }
            if (lag == 0 && co == ci) s += ka->in[14][lg * 16 + co];
            KMAT[it] = s;
        }
    }
            }
        { KArgs ka = kargs(); const int G = gridDim.x, cu = blockIdx.x;
          pg8::Gemm g{WSP(bf16, WS_XN), WL(WO_UP1), T, NUP, DM, DM, DM}; pg8::StaticOrder S; S.init(T, NUP, G, cu); EpiSwiGlu E{WSP(bf16, WS_H), FF, l * 3 + 0};
          pg8::gemm_phase<EpiSwiGlu, pg8::StaticOrder, true, true>(lds, g, S, E, wid_s); }
        GRID_SYNC();
        if (l == 0) {
    {
        KArgs ka = kargs(); unsigned char* ws = ka->ws; const f32x2* APOW = (const f32x2*)(ws + WS_APOW); const f32x2* BBAR = (const f32x2*)(ws + WS_BBAR); const float* KMAT = (const float*)(ws + WS_KMAT);
        unsigned z_ = 0u; asm volatile("" : "+v"(z_)); const int tid = wid_s * 64 + (int)__builtin_amdgcn_mbcnt_hi(~0u, __builtin_amdgcn_mbcnt_lo(~0u, z_)); const int gtid = blockIdx.x * 512 + tid, NT = gridDim.x * 512;
#pragma unroll 2
        for (int it = gtid; it < 2 * 16 * BS5_ROWS * 144; it += NT) {
            const int k8 = it % 144; const int n = (it / 144) % BS5_ROWS; const int lg = it / (144 * BS5_ROWS); const int l = lg >> 4, g = lg & 15;
            float v[8];
#pragma unroll
            for (int q = 0; q < 8; ++q) v[q] = 0.f;
            if (n < 1024) { const int i = n >> 4, co = n & 15;
                if (k8 < 128) { const int j = k8 >> 1, ci0 = (k8 & 1) * 8;
                    if (j <= i) { const f32x4* kp = (const f32x4*)(KMAT + (((size_t)lg * 64 + (i - j)) * 16 + co) * 16 + ci0); const f32x4 a = kp[0], b = kp[1]; v[0] = a.x; v[1] = a.y; v[2] = a.z; v[3] = a.w; v[4] = b.x; v[5] = b.y; v[6] = b.z; v[7] = b.w; }
                } else { const int p0 = (k8 - 128) * 4;
#pragma unroll
                    for (int q = 0; q < 4; ++q) { const int p = p0 + q; const float cre = ka->in[12][((size_t)lg * 16 + co) * 64 + p], cim = ka->in[13][((size_t)lg * 16 + co) * 64 + p]; const f32x2 a = APOW[((size_t)lg * 65 + i + 1) * 64 + p];
                        v[2 * q] = cre * a.x - cim * a.y; v[2 * q + 1] = -(cre * a.y + cim * a.x); } }
            } else if (n < 1152) { const int s = n & 1, p = (n - 1024) >> 1;
                if (k8 < 128) { const int j = k8 >> 1, ci0 = (k8 & 1) * 8; const f32x2 a = APOW[((size_t)lg * 65 + 63 - j) * 64 + p];
#pragma unroll
                    for (int q = 0; q < 8; ++q) { const f32x2 b = BBAR[((size_t)lg * 64 + p) * 16 + ci0 + q]; v[q] = s ? (a.x * b.y + a.y * b.x) : (a.x * b.x - a.y * b.y); } }
            }
            v4u w; w.x = pk2(v[0], v[1]); w.y = pk2(v[2], v[3]); w.z = pk2(v[4], v[5]); w.w = pk2(v[6], v[7]);
            *(v4u*)((bf16*)(ws + WS_W + (size_t)l * W_LSTRIDE + WO_BS5) + ((size_t)(g * BS5_ROWS + n) * AS5_LD + k8 * 8)) = w;
        }
    }
            }
        { KArgs ka = kargs(); const int G = gridDim.x, cu = blockIdx.x;
          pg8::Gemm g{WSP(bf16, WS_H), WL(WO_DN1), T, DM, FF, FF, FF}; pg8::StaticOrder S; S.init(T, DM, G, cu); EpiResid E{0, 0.5f, l * 3 + 1};
          pg8::gemm_phase<EpiResid, pg8::StaticOrder, true, true>(lds, g, S, E, wid_s); }
        GRID_SYNC();
        { KArgs ka = kargs(); const int G = gridDim.x, cu = blockIdx.x;
          pg8::Gemm g{WSP(bf16, WS_XN), WL(WO_IN), T, INC, DM, DM, DM}; pg8::StaticOrder S; S.init(T, INC, G, cu);
          EpiIn E{WSP(bf16, WS_AS5), WSP(bf16, WS_Q), WSP(bf16, WS_ZG), (unsigned char*)(ka->ws + WS_G), l * 3 + 1, ka->in[6] + l * 3072};
          pg8::gemm_phase<EpiIn, pg8::StaticOrder, true, true>(lds, g, S, E, wid_s); }
        GRID_SYNC();
        { KArgs ka = kargs(); const int G = gridDim.x, cu = blockIdx.x;
          pg8::Gemm g{WSP(bf16, WS_AS5), WL(WO_BS5), 16 * 1024, 16 * BS5_ROWS, 1024, AS5_LD, AS5_LD}; S5Order1 S{G, cu}; EpiS5State E{WSP(bf16, WS_AS5), WSP(const f32x2, WS_APOW) + (size_t)l * 16 * 65 * 64};
          pg8::gemm_phase<EpiS5State, S5Order1, false, true>(lds, g, S, E, wid_s); }
        __syncthreads();
        { KArgs ka = kargs(); attn_phase(lds, WSP(bf16, WS_Q), WSP(bf16, WS_K), WSP(bf16, WS_V), (bf16*)ka->out, ka->in[17] + l * 64, ka->in[18] + l * 64, ka->in[19] + l * 8 * 257, wid_s); }
        { KArgs ka = kargs(); conv_phase(lds, WSP(bf16, WS_ZG), (bf16*)ka->out, ka->in[21] + l * 31 * 256, ka->in[22] + l * 256, ka->in[23] + l * 256, ka->in[24] + l * 256, wid_s); }
        GRID_SYNC();
        { KArgs ka = kargs(); const int G = gridDim.x, cu = blockIdx.x;
          pg8::Gemm g{WSP(bf16, WS_AS5), WL(WO_BS5), 16 * 1024, 16 * BS5_ROWS, AS5_LD, AS5_LD, AS5_LD}; S5Order2 S{G, cu}; EpiS5Y E{WSP(bf16, WS_ZG)};
          pg8::gemm_phase<EpiS5Y, S5Order2, true, true>(lds, g, S, E, wid_s); }
        GRID_SYNC();
        { KArgs ka = kargs(); const int G = gridDim.x, cu = blockIdx.x;
          pg8::Gemm g{WSP(bf16, WS_ZG), WL(WO_GLU), T, 512, 256, 256, 256}; pg8::StaticOrder S; S.init(T, 512, G, cu); EpiGlu<1> E{(bf16*)ka->out, DM, 0, -1};
          pg8::gemm_phase<EpiGlu<1>, pg8::StaticOrder, true, true>(lds, g, S, E, wid_s); }
        GRID_SYNC();
        { KArgs ka = kargs(); const int G = gridDim.x, cu = blockIdx.x;
          pg8::Gemm g{(const bf16*)ka->out, WL(WO_BR), T, DM, DM, DM, DM}; BranchOrder S; S.base.init(T, DM, G, cu); EpiBranchSeg E{(const unsigned char*)(ka->ws + WS_G), WSP(bf16, WS_MG)};
          pg8::gemm_phase<EpiBranchSeg, BranchOrder, true, true>(lds, g, S, E, wid_s); }
        GRID_SYNC();
        { KArgs ka = kargs(); const int G = gridDim.x, cu = blockIdx.x;
          pg8::Gemm g{WSP(bf16, WS_MG), WL(WO_OUT), T, DM, DM, DM, DM}; pg8::StaticOrder S; S.init(T, DM, G, cu); EpiResid E{0, 1.0f, l * 3 + 2};
          pg8::gemm_phase<EpiResid, pg8::StaticOrder, true, true>(lds, g, S, E, wid_s); }
        GRID_SYNC();
        { KArgs ka = kargs(); const int G = gridDim.x, cu = blockIdx.x;
          pg8::Gemm g{WSP(bf16, WS_XN), WL(WO_UP2), T, NUP, DM, DM, DM}; pg8::StaticOrder S; S.init(T, NUP, G, cu); EpiSwiGlu E{WSP(bf16, WS_H), FF, l * 3 + 2};
          pg8::gemm_phase<EpiSwiGlu, pg8::StaticOrder, true, true>(lds, g, S, E, wid_s); }
        GRID_SYNC();
        { KArgs ka = kargs(); const int G = gridDim.x, cu = blockIdx.x;
          pg8::Gemm g{WSP(bf16, WS_H), WL(WO_DN2), T, DM, FF, FF, FF}; pg8::StaticOrder S; S.init(T, DM, G, cu); EpiResid E{l == 1 ? 1 : 0, 0.5f, l == 0 ? 3 : -1};
          pg8::gemm_phase<EpiResid, pg8::StaticOrder, true, true>(lds, g, S, E, wid_s); }
        if (l == 0) GRID_SYNC();
    }
}

extern "C" void kernel_launch(void* const* d_in, const int* in_sizes, int n_in, void* d_out, int out_size, void* d_ws, size_t ws_size, hipStream_t stream) {
    static int grid = 0;
    if (grid == 0) {
        if (n_in != 30 || out_size != T * DM || ws_size < WS_END) { fprintf(stderr, "kernel_launch: unexpected shapes (n_in %d, out %d, ws %zu)\n", n_in, out_size, ws_size); grid = -1; return; }
        int dev = 0, cus = 0, per_cu = 0;
        hipGetDevice(&dev); hipDeviceGetAttribute(&cus, hipDeviceAttributeMultiprocessorCount, dev);
        hipFuncSetAttribute((const void*)fwd_megakernel, hipFuncAttributeMaxDynamicSharedMemorySize, LDS_BYTES);
        hipOccupancyMaxActiveBlocksPerMultiprocessor(&per_cu, (const void*)fwd_megakernel, NWAVES * 64, LDS_BYTES);
        if (per_cu < 1) { fprintf(stderr, "kernel_launch: occupancy query says %d blocks per CU\n", per_cu); per_cu = 1; }
        (void)hipGetLastError();
        grid = cus * 1;
    }
    if (grid < 0) return;
    (void)hipMemsetAsync(d_ws, 0, 65536, stream);
    Args a{};
    for (int i = 0; i < 30; ++i) a.in[i] = (const float*)d_in[i];
    a.out = (float*)d_out; a.ws = (unsigned char*)d_ws;
    void* kargs[] = {&a};
    hipError_t e = hipLaunchCooperativeKernel((const void*)fwd_megakernel, dim3(grid), dim3(NWAVES * 64), kargs, LDS_BYTES, stream);
    if (e != hipSuccess) fprintf(stderr, "cooperative launch failed: %s (grid %d)\n", hipGetErrorString(e), grid);
}
```
